# Optimizing an MI355X kernel written in HIP

```python
import jax, jax.numpy as jnp
from jax import lax
import numpy as np

D_MODEL = 4096
BATCH = 4
SEQ = 4096
DEPTH = 2

N_MIXERS = 2
SELF_WIDTH = 3 * D_MODEL // 4
HEAD_DIM = 128
N_SELF_HEADS = SELF_WIDTH // HEAD_DIM
MEM_LEN = 256
N_MEM_HEADS = 4
MEM_HEAD_DIM = (D_MODEL - SELF_WIDTH) // N_MEM_HEADS
MEM_WIDTH = N_MEM_HEADS * MEM_HEAD_DIM
Q_LORA_RANK = 1536
KV_LORA_RANK = 512
QK_NOPE_DIM = 128
QK_ROPE_DIM = 64
V_HEAD_DIM = SELF_WIDTH // N_SELF_HEADS
ROPE_THETA = 10000.0
D_FF = 4 * D_MODEL
Q_BLOCK = 128
NORM_EPS = 1e-6
FOX_IN = 3 * SELF_WIDTH + N_SELF_HEADS + MEM_WIDTH
MLA_IN = Q_LORA_RANK + KV_LORA_RANK + QK_ROPE_DIM + MEM_WIDTH
N_FOX_LAYERS = (DEPTH + N_MIXERS - 1) // N_MIXERS
N_MLA_LAYERS = DEPTH // N_MIXERS

kernel_name = "fox_mla_hybrid_memory_trunk"


def rms_norm(x, g):
    xf = x.astype(jnp.float32)
    y = xf * lax.rsqrt(jnp.mean(xf * xf, axis=-1, keepdims=True) + NORM_EPS)
    return (y * g.astype(jnp.float32)).astype(x.dtype)


def rope_tables(positions):
    inv_freq = 1.0 / (ROPE_THETA ** (jnp.arange(0, QK_ROPE_DIM, 2, dtype=jnp.float32) / QK_ROPE_DIM))
    ang = positions.astype(jnp.float32)[..., None] * inv_freq
    return jnp.cos(ang)[:, :, None, :], jnp.sin(ang)[:, :, None, :]


def apply_rope(x, cos, sin):
    xf = x.astype(jnp.float32)
    x1, x2 = jnp.split(xf, 2, axis=-1)
    return jnp.concatenate([x1 * cos - x2 * sin, x2 * cos + x1 * sin], axis=-1).astype(x.dtype)


def causal_block_attention(q, k, v, decay_cum=None):
    b, s, h, dk = q.shape
    nb = s // Q_BLOCK
    scale = dk ** -0.5
    q_blocks = jnp.moveaxis(q.reshape(b, nb, Q_BLOCK, h, dk), 1, 0)
    key_pos = jnp.arange(s)
    xs = [jnp.arange(nb), q_blocks]
    if decay_cum is not None:
        key_decay = jnp.transpose(decay_cum, (0, 2, 1))[:, :, None, :]
        xs.append(jnp.moveaxis(decay_cum.reshape(b, nb, Q_BLOCK, h), 1, 0))

    def one_block(args):
        blk, q_blk = args[0], args[1]
        scores = jnp.einsum('bqhd,bkhd->bhqk', q_blk, k).astype(jnp.float32) * scale
        if decay_cum is not None:
            query_decay = jnp.transpose(args[2], (0, 2, 1))[..., None]
            scores = scores + (query_decay - key_decay)
        query_pos = blk * Q_BLOCK + jnp.arange(Q_BLOCK)
        causal = key_pos[None, :] <= query_pos[:, None]
        scores = jnp.where(causal, scores, -jnp.inf)
        probs = jax.nn.softmax(scores, axis=-1).astype(v.dtype)
        return jnp.einsum('bhqk,bkhd->bqhd', probs, v)

    out = lax.map(one_block, tuple(xs))
    return jnp.moveaxis(out, 0, 1).reshape(b, s, h, v.shape[-1])


def memory_branch(q_mem, memq_norm_g, mem_k, mem_v):
    b, s, _ = q_mem.shape
    q = rms_norm(q_mem.reshape(b, s, N_MEM_HEADS, MEM_HEAD_DIM), memq_norm_g)
    scores = jnp.einsum('bqhd,bmhd->bhqm', q, mem_k).astype(jnp.float32) * (MEM_HEAD_DIM ** -0.5)
    probs = jax.nn.softmax(scores, axis=-1).astype(mem_v.dtype)
    return jnp.einsum('bhqm,bmhd->bqhd', probs, mem_v).reshape(b, s, MEM_WIDTH)


def fox_mixer(h, w_in, b_f, q_norm_g, k_norm_g, memq_norm_g, mem_k, mem_v):
    b, s, _ = h.shape
    proj = h @ w_in
    q, k, v, f_logit, q_mem = jnp.split(
        proj, [SELF_WIDTH, 2 * SELF_WIDTH, 3 * SELF_WIDTH, 3 * SELF_WIDTH + N_SELF_HEADS], axis=-1)
    q = rms_norm(q.reshape(b, s, N_SELF_HEADS, HEAD_DIM), q_norm_g)
    k = rms_norm(k.reshape(b, s, N_SELF_HEADS, HEAD_DIM), k_norm_g)
    v = v.reshape(b, s, N_SELF_HEADS, HEAD_DIM)
    log_f = jax.nn.log_sigmoid((f_logit + b_f).astype(jnp.float32))
    decay_cum = jnp.cumsum(log_f, axis=1)
    o_self = causal_block_attention(q, k, v, decay_cum).reshape(b, s, SELF_WIDTH)
    o_mem = memory_branch(q_mem, memq_norm_g, mem_k, mem_v)
    return jnp.concatenate([o_self, o_mem], axis=-1)


def mla_mixer(h, cos, sin, w_in, q_a_norm_g, w_q_b, kv_a_norm_g, w_kv_b, q_norm_g, k_norm_g,
              memq_norm_g, mem_k, mem_v):
    b, s, _ = h.shape
    proj = h @ w_in
    c_q, c_kv, k_rope, q_mem = jnp.split(
        proj, [Q_LORA_RANK, Q_LORA_RANK + KV_LORA_RANK, Q_LORA_RANK + KV_LORA_RANK + QK_ROPE_DIM], axis=-1)
    q = (rms_norm(c_q, q_a_norm_g) @ w_q_b).reshape(b, s, N_SELF_HEADS, QK_NOPE_DIM + QK_ROPE_DIM)
    kv = (rms_norm(c_kv, kv_a_norm_g) @ w_kv_b).reshape(b, s, N_SELF_HEADS, QK_NOPE_DIM + V_HEAD_DIM)
    k_nope, v = jnp.split(kv, [QK_NOPE_DIM], axis=-1)
    k_rope = jnp.broadcast_to(k_rope[:, :, None, :], (b, s, N_SELF_HEADS, QK_ROPE_DIM))
    k = jnp.concatenate([k_nope, k_rope], axis=-1)
    q = rms_norm(q, q_norm_g)
    k = rms_norm(k, k_norm_g)
    q = jnp.concatenate([q[..., :QK_NOPE_DIM], apply_rope(q[..., QK_NOPE_DIM:], cos, sin)], axis=-1)
    k = jnp.concatenate([k[..., :QK_NOPE_DIM], apply_rope(k[..., QK_NOPE_DIM:], cos, sin)], axis=-1)
    o_self = causal_block_attention(q, k, v).reshape(b, s, SELF_WIDTH)
    o_mem = memory_branch(q_mem, memq_norm_g, mem_k, mem_v)
    return jnp.concatenate([o_self, o_mem], axis=-1)


def _dense(key, shape, fan_in):
    return jax.random.normal(key, shape, jnp.float32) * (fan_in ** -0.5)


def _gain(key, shape):
    return 1.0 + 0.02 * jax.random.normal(key, shape, jnp.float32)


def setup_inputs(seed: int = 0) -> dict:
    key = jax.random.key(seed)
    ks = jax.random.split(key, 24)
    nf, nm = N_FOX_LAYERS, N_MLA_LAYERS
    positions = (jax.random.randint(ks[2], (BATCH, 1), 0, 1024, dtype=jnp.int32)
                 + jnp.arange(SEQ, dtype=jnp.int32)[None, :])
    return {
        "x": jax.random.normal(ks[0], (BATCH, SEQ, D_MODEL), jnp.float32),
        "mem": jax.random.normal(ks[1], (BATCH, MEM_LEN, D_MODEL), jnp.float32),
        "positions": positions,
        "mem_norm_g": _gain(ks[3], (D_MODEL,)),
        "w_mem_kv": _dense(ks[4], (D_MODEL, 2 * MEM_WIDTH), D_MODEL),
        "mem_k_norm_g": _gain(ks[5], (MEM_HEAD_DIM,)),
        "attn_norm_g": _gain(ks[6], (DEPTH, D_MODEL)),
        "memq_norm_g": _gain(ks[7], (DEPTH, MEM_HEAD_DIM)),
        "w_o": _dense(ks[8], (DEPTH, D_MODEL, D_MODEL), D_MODEL),
        "mlp_norm_g": _gain(ks[9], (DEPTH, D_MODEL)),
        "w_up": _dense(ks[10], (DEPTH, D_MODEL, D_FF), D_MODEL),
        "w_down": _dense(ks[11], (DEPTH, D_FF, D_MODEL), D_FF),
        "fox_w_in": _dense(ks[12], (nf, D_MODEL, FOX_IN), D_MODEL),
        "fox_b_f": 2.0 + 0.5 * jax.random.normal(ks[13], (nf, N_SELF_HEADS), jnp.float32),
        "fox_q_norm_g": _gain(ks[14], (nf, HEAD_DIM)),
        "fox_k_norm_g": _gain(ks[15], (nf, HEAD_DIM)),
        "mla_w_in": _dense(ks[16], (nm, D_MODEL, MLA_IN), D_MODEL),
        "mla_q_a_norm_g": _gain(ks[17], (nm, Q_LORA_RANK)),
        "mla_w_q_b": _dense(ks[18], (nm, Q_LORA_RANK, N_SELF_HEADS * (QK_NOPE_DIM + QK_ROPE_DIM)), Q_LORA_RANK),
        "mla_kv_a_norm_g": _gain(ks[19], (nm, KV_LORA_RANK)),
        "mla_w_kv_b": _dense(ks[20], (nm, KV_LORA_RANK, N_SELF_HEADS * (QK_NOPE_DIM + V_HEAD_DIM)), KV_LORA_RANK),
        "mla_q_norm_g": _gain(ks[21], (nm, QK_NOPE_DIM + QK_ROPE_DIM)),
        "mla_k_norm_g": _gain(ks[22], (nm, QK_NOPE_DIM + QK_ROPE_DIM)),
    }


def reference(x, mem, positions, mem_norm_g, w_mem_kv, mem_k_norm_g, attn_norm_g, memq_norm_g, w_o,
              mlp_norm_g, w_up, w_down, fox_w_in, fox_b_f, fox_q_norm_g, fox_k_norm_g, mla_w_in,
              mla_q_a_norm_g, mla_w_q_b, mla_kv_a_norm_g, mla_w_kv_b, mla_q_norm_g, mla_k_norm_g):
    b, m, _ = mem.shape
    mem_k, mem_v = jnp.split(rms_norm(mem, mem_norm_g) @ w_mem_kv, 2, axis=-1)
    mem_k = rms_norm(mem_k.reshape(b, m, N_MEM_HEADS, MEM_HEAD_DIM), mem_k_norm_g)
    mem_v = mem_v.reshape(b, m, N_MEM_HEADS, MEM_HEAD_DIM)
    cos, sin = rope_tables(positions)
    for layer in range(DEPTH):
        j = layer // N_MIXERS
        h = rms_norm(x, attn_norm_g[layer])
        if layer % N_MIXERS == 0:
            mixed = fox_mixer(h, fox_w_in[j], fox_b_f[j], fox_q_norm_g[j], fox_k_norm_g[j],
                              memq_norm_g[layer], mem_k, mem_v)
        else:
            mixed = mla_mixer(h, cos, sin, mla_w_in[j], mla_q_a_norm_g[j], mla_w_q_b[j],
                              mla_kv_a_norm_g[j], mla_w_kv_b[j], mla_q_norm_g[j], mla_k_norm_g[j],
                              memq_norm_g[layer], mem_k, mem_v)
        x = x + mixed @ w_o[layer]
        h = rms_norm(x, mlp_norm_g[layer])
        x = x + jnp.square(jax.nn.relu(h @ w_up[layer])) @ w_down[layer]
    return x
```

```cpp
#include <hip/hip_runtime.h>
#include <cstdio>
#include <cstdint>
#include <cstring>

#define LAS __attribute__((address_space(3)))
#define GAS __attribute__((address_space(1)))
typedef unsigned short bf16;
typedef short bf16x8 __attribute__((ext_vector_type(8)));
typedef short s16x4 __attribute__((ext_vector_type(4)));
typedef float f32x2 __attribute__((ext_vector_type(2)));
typedef float f32x4 __attribute__((ext_vector_type(4)));
typedef float f32x8 __attribute__((ext_vector_type(8)));
typedef float f32x16 __attribute__((ext_vector_type(16)));
typedef unsigned u32x4 __attribute__((ext_vector_type(4)));
typedef unsigned u32x2 __attribute__((ext_vector_type(2)));

#ifndef HID_BLK
#define HID_BLK 1
#endif
#ifndef A_BLK
#define A_BLK 1
#endif
constexpr int NB = 4, SEQ = 4096, T = NB * SEQ, DM = 4096, NH = 24, FF = 16384, MLEN = 256, MT = NB * MLEN, NMH = 4;
constexpr int FOX_SRC = 10264, FOXN = 10496;
constexpr int MLA_SRC = 3136, MLAN = 3328;
constexpr int QLR = 1536, KVLR = 512, QBN = 4608, KVBN = 6144;
constexpr float EPS = 1e-6f, LOG2E = 1.4426950408889634f;
__device__ __forceinline__ size_t act_off(int row, int col, int M, int ld) { return A_BLK ? ((size_t)(col >> 6) * M + row) * 64 + (col & 63) : (size_t)row * ld + col; }

__device__ __forceinline__ int lane_id() { int l; asm volatile("v_mbcnt_lo_u32_b32 %0, -1, 0\n\tv_mbcnt_hi_u32_b32 %0, -1, %0" : "=v"(l)); return l; }
__device__ __forceinline__ int tid_of(int wv) { return (wv << 6) | lane_id(); }

namespace pg8 {
constexpr int BM = 256, BK = 64, HALF = 128, HTB = HALF * BK * 2, STAGE_BYTES = 8 * HTB, NXCD = 8, WGM = 8;
__host__ __device__ __forceinline__ int lds_byte(int r, int c) { const int st = (r >> 4) * 2 + (c >> 5), rr = r & 15, cc = c & 31, ob = rr * 64 + cc * 2; return st * 1024 + (ob ^ (((ob >> 9) & 1) << 5)); }
__host__ __device__ __forceinline__ void stage_rc(int b, int& R, int& C) { const int st = b / 1024, sb = b % 1024, swz = sb ^ (((sb >> 9) & 1) << 5); R = (st >> 1) * 16 + swz / 64; C = (st & 1) * 32 + (swz % 64) / 2; }
__host__ __device__ __forceinline__ int perm32(int rho) { const int n = rho >> 4, i = rho & 15; return 8 * (i >> 2) + 4 * n + (i & 3); }
struct Unit { int pm, pn; };
struct Gemm { const bf16* A; const bf16* Bt; int M, N, K; int bblk; int ablk; };
struct StaticOrder {
    int nM, nN, nwg, G, c;
    __device__ void init(int M, int N, int G_, int c_) { nM = M / BM; nN = N / BM; nwg = nM * nN; G = G_; c = c_; }
    __device__ bool next(int i, Unit& u) const {
        const long L = (long)i * G + c; if (L >= nwg) return false;
        int wgid = (int)L; { const int q = nwg / NXCD, r = nwg % NXCD, xcd = wgid % NXCD, off = wgid / NXCD; wgid = (xcd < r ? xcd * (q + 1) : r * (q + 1) + (xcd - r) * q) + off; }
        const int nig = WGM * nN, gid = wgid / nig, fm = gid * WGM, gsz = (nM - fm) < WGM ? (nM - fm) : WGM;
        u.pm = fm + ((wgid % nig) % gsz); u.pn = (wgid % nig) / gsz; return true;
    }
    __device__ __forceinline__ void a_ready(const Unit&) const {}
    __device__ __forceinline__ void done(const Unit&) const {}
};
typedef __bf16 bf16x2_t __attribute__((ext_vector_type(2)));
__device__ __forceinline__ unsigned cvt_pk_bf16(float lo, float hi) { const f32x2 v = {lo, hi}; const bf16x2_t b = __builtin_convertvector(v, bf16x2_t); return __builtin_bit_cast(unsigned, b); }

template <class Epi, class Sched, bool ALIGN_EPI = false, bool SP2 = false>
__device__ __forceinline__ void gemm_phase(LAS unsigned char* lds, const Gemm g, const Sched& S, const Epi& E, const int wv) {
    int tid = tid_of(wv); asm volatile("" : "+v"(tid));
    const int wid = __builtin_amdgcn_readfirstlane(tid >> 6), lane = tid & 63, wr = wid >> 2, wc = wid & 3, fr = lane & 15, fq = lane >> 4;
    const int K = g.K, nt = K / BK;
    unsigned voffA[2], voffB[2];
#pragma unroll
    for (int i = 0; i < 2; ++i) { int R, C; stage_rc(tid * 16 + i * 8192, R, C); const int Rb = Epi::PERM ? ((R & ~31) + perm32(R & 31)) : R;
        voffA[i] = (unsigned)(R * (g.ablk ? BK : K) + C) * 2u; voffB[i] = (unsigned)(Rb * (g.bblk ? BK : K) + C) * 2u; }
    const size_t kstep = (size_t)(BK * 2);
    const size_t hstep = (size_t)HALF * K * 2;
    const size_t tstep = 2 * hstep;
    const size_t kstepA = g.ablk ? (size_t)g.M * BK * 2 : kstep, hstepA = g.ablk ? (size_t)HALF * BK * 2 : hstep, tstepA = 2 * hstepA;
    const size_t kstepB = g.bblk ? (size_t)g.N * BK * 2 : kstep, hstepB = g.bblk ? (size_t)HALF * BK * 2 : hstep, tstepB = 2 * hstepB;
    const unsigned ldsw = (unsigned)wid * 1024u;
    const int aoff = lds_byte(wr * 64 + fr, fq * 8), boff = lds_byte(wc * 32 + fr, fq * 8);
#define PG8_SA(b, h) (((b) * 2 + (h)) * HTB)
#define PG8_SB(b, h) ((4 + (b) * 2 + (h)) * HTB)
#define PG8_STAGE(bufoff, gbase, voff) do { _Pragma("unroll") for (int _i = 0; _i < 2; ++_i) \
        __builtin_amdgcn_global_load_lds((const unsigned*)((const char*)(gbase) + (voff)[_i]), (LAS unsigned*)(lds + (bufoff) + ldsw + _i * 8192), 16, 0, 0); } while (0)
#define PG8_LDA(dst, b, h) do { _Pragma("unroll") for (int m = 0; m < 4; ++m) _Pragma("unroll") for (int k = 0; k < 2; ++k) dst[m][k] = *(const LAS bf16x8*)(lds + PG8_SA(b, h) + aoff + m * 2048 + k * 1024); } while (0)
#define PG8_LDB(dst, b, h) do { _Pragma("unroll") for (int n = 0; n < 2; ++n) _Pragma("unroll") for (int k = 0; k < 2; ++k) dst[n][k] = *(const LAS bf16x8*)(lds + PG8_SB(b, h) + boff + n * 2048 + k * 1024); } while (0)
#define PG8_MMA(ai, bj, At, Bt) do { __builtin_amdgcn_s_setprio(1); _Pragma("unroll") for (int m = 0; m < 4; ++m) _Pragma("unroll") for (int n = 0; n < 2; ++n) _Pragma("unroll") for (int k = 0; k < 2; ++k) \
        acc[ai][bj][m][n] = __builtin_amdgcn_mfma_f32_16x16x32_bf16(Bt[n][k], At[m][k], acc[ai][bj][m][n], 0, 0, 0); __builtin_amdgcn_s_setprio(0); } while (0)
#define PG8_WAIT_V(n) asm volatile("s_waitcnt vmcnt(" #n ")" ::: "memory")
#define PG8_WAIT_L(n) asm volatile("s_waitcnt lgkmcnt(" #n ")" ::: "memory")
#define PG8_BAR __builtin_amdgcn_s_barrier()
#define PG8_SCHED __builtin_amdgcn_sched_barrier(0)
    Unit cur, nxt; int ui = 0;
    if (!S.next(0, cur)) return;
    f32x4 acc[2][2][4][2];
#pragma unroll
    for (int a = 0; a < 2; ++a)
#pragma unroll
        for (int b = 0; b < 2; ++b)
#pragma unroll
            for (int m = 0; m < 4; ++m)
#pragma unroll
                for (int n = 0; n < 2; ++n) acc[a][b][m][n] = (f32x4){0.f, 0.f, 0.f, 0.f};
    bf16x8 At[4][2], B0[2][2], B1[2][2];
    const char* cA = (const char*)g.A + (size_t)cur.pm * tstepA; const char* cB = (const char*)g.Bt + (size_t)cur.pn * tstepB;
    S.a_ready(cur);
    if constexpr (SP2) {
        PG8_STAGE(PG8_SB(0, 0), cB, voffB); PG8_STAGE(PG8_SB(0, 1), cB + hstepB, voffB); PG8_STAGE(PG8_SA(0, 0), cA, voffA); PG8_STAGE(PG8_SA(0, 1), cA + hstepA, voffA);
        if (wr == 1) PG8_BAR;
        PG8_WAIT_V(2); PG8_BAR;
        PG8_STAGE(PG8_SB(1, 0), cB + kstepB, voffB); PG8_STAGE(PG8_SA(1, 0), cA + kstepA, voffA); PG8_STAGE(PG8_SB(1, 1), cB + hstepB + kstepB, voffB);
        PG8_WAIT_V(6); PG8_BAR;
    } else {
        PG8_STAGE(PG8_SB(0, 0), cB, voffB); PG8_STAGE(PG8_SA(0, 0), cA, voffA); PG8_STAGE(PG8_SB(0, 1), cB + hstepB, voffB); PG8_STAGE(PG8_SA(0, 1), cA + hstepA, voffA);
        if (wr == 1) PG8_BAR;
        PG8_WAIT_V(4); PG8_BAR;
        PG8_STAGE(PG8_SB(1, 0), cB + kstepB, voffB); PG8_STAGE(PG8_SA(1, 0), cA + kstepA, voffA); PG8_STAGE(PG8_SB(1, 1), cB + hstepB + kstepB, voffB);
        PG8_WAIT_V(6); PG8_BAR;
    }
    for (;;) {
        const bool has_next = S.next(ui + 1, nxt);
        const char* nA = has_next ? (const char*)g.A + (size_t)nxt.pm * tstepA : cA; const char* nB = has_next ? (const char*)g.Bt + (size_t)nxt.pn * tstepB : cB;
        for (int t = 0; t < nt; t += 2) {
            const bool last = (t == nt - 2);
            const char* a1 = cA + (size_t)(t + 1) * kstepA;
            const char* a2 = last ? nA : cA + (size_t)(t + 2) * kstepA; const char* b2 = last ? nB : cB + (size_t)(t + 2) * kstepB;
            const char* a3 = a2 + kstepA; const char* b3 = b2 + kstepB;
            if (last && has_next) S.a_ready(nxt);
            if constexpr (SP2) {
            PG8_LDB(B0, 0, 0); PG8_LDB(B1, 0, 1); PG8_SCHED; PG8_LDA(At, 0, 0); PG8_STAGE(PG8_SA(1, 1), a1 + hstepA, voffA);
            PG8_WAIT_V(8); PG8_WAIT_L(0); PG8_BAR; PG8_MMA(0, 0, At, B0); PG8_MMA(0, 1, At, B1); PG8_BAR; PG8_SCHED;
            PG8_LDA(At, 0, 1); PG8_STAGE(PG8_SB(0, 0), b2, voffB); PG8_STAGE(PG8_SB(0, 1), b2 + hstepB, voffB); PG8_STAGE(PG8_SA(0, 0), a2, voffA);
            PG8_WAIT_V(8); PG8_WAIT_L(0); PG8_BAR; PG8_MMA(1, 0, At, B0); PG8_MMA(1, 1, At, B1); PG8_BAR; PG8_SCHED;
            PG8_LDB(B0, 1, 0); PG8_LDB(B1, 1, 1); PG8_SCHED; PG8_LDA(At, 1, 0); PG8_STAGE(PG8_SA(0, 1), a2 + hstepA, voffA);
            PG8_WAIT_V(8); PG8_WAIT_L(0); PG8_BAR; PG8_MMA(0, 0, At, B0); PG8_MMA(0, 1, At, B1); PG8_BAR; PG8_SCHED;
            PG8_LDA(At, 1, 1); PG8_STAGE(PG8_SB(1, 0), b3, voffB); PG8_STAGE(PG8_SB(1, 1), b3 + hstepB, voffB); PG8_STAGE(PG8_SA(1, 0), a3, voffA);
            PG8_WAIT_V(8); PG8_WAIT_L(0); PG8_BAR; PG8_MMA(1, 0, At, B0); PG8_MMA(1, 1, At, B1); PG8_BAR; PG8_SCHED;
            } else {
            PG8_LDB(B0, 0, 0); PG8_SCHED; PG8_LDA(At, 0, 0); PG8_STAGE(PG8_SA(1, 1), a1 + hstepA, voffA);
            PG8_WAIT_L(8); PG8_BAR; PG8_WAIT_L(0); PG8_MMA(0, 0, At, B0); PG8_BAR; PG8_SCHED;
            PG8_LDB(B1, 0, 1); PG8_STAGE(PG8_SB(0, 0), b2, voffB);
            PG8_BAR; PG8_WAIT_L(0); PG8_MMA(0, 1, At, B1); PG8_BAR;
            PG8_LDA(At, 0, 1); PG8_STAGE(PG8_SA(0, 0), a2, voffA);
            PG8_BAR; PG8_WAIT_L(0); PG8_MMA(1, 0, At, B0); PG8_BAR; PG8_SCHED;
            PG8_STAGE(PG8_SB(0, 1), b2 + hstepB, voffB);
            PG8_WAIT_V(6); PG8_BAR; PG8_MMA(1, 1, At, B1); PG8_BAR;
            PG8_LDB(B0, 1, 0); PG8_SCHED; PG8_LDA(At, 1, 0); PG8_STAGE(PG8_SA(0, 1), a2 + hstepA, voffA);
            PG8_WAIT_L(8); PG8_BAR; PG8_WAIT_L(0); PG8_MMA(0, 0, At, B0); PG8_BAR; PG8_SCHED;
            PG8_LDB(B1, 1, 1); PG8_STAGE(PG8_SB(1, 0), b3, voffB);
            PG8_BAR; PG8_WAIT_L(0); PG8_MMA(0, 1, At, B1); PG8_BAR;
            PG8_LDA(At, 1, 1); PG8_STAGE(PG8_SA(1, 0), a3, voffA);
            PG8_BAR; PG8_WAIT_L(0); PG8_MMA(1, 0, At, B0); PG8_BAR; PG8_SCHED;
            PG8_STAGE(PG8_SB(1, 1), b3 + hstepB, voffB);
            PG8_WAIT_V(6); PG8_BAR; PG8_MMA(1, 1, At, B1); PG8_BAR;
            }
        }
        if constexpr (ALIGN_EPI) { if (wr == 0) PG8_BAR; }
        E(acc, cur, wr, wc, fr, fq); S.done(cur);
        if (!has_next) break;
#pragma unroll
        for (int a = 0; a < 2; ++a)
#pragma unroll
            for (int b = 0; b < 2; ++b)
#pragma unroll
                for (int m = 0; m < 4; ++m)
#pragma unroll
                    for (int n = 0; n < 2; ++n) acc[a][b][m][n] = (f32x4){0.f, 0.f, 0.f, 0.f};
        cur = nxt; cA = nA; cB = nB; ++ui;
        if constexpr (ALIGN_EPI) { if (wr == 1) PG8_BAR; }
    }
    PG8_WAIT_V(0);
    if constexpr (!ALIGN_EPI) { if (wr == 0) PG8_BAR; }
    PG8_BAR;
#undef PG8_SA
#undef PG8_SB
#undef PG8_STAGE
#undef PG8_LDA
#undef PG8_LDB
#undef PG8_MMA
#undef PG8_WAIT_V
#undef PG8_WAIT_L
#undef PG8_BAR
#undef PG8_SCHED
}
}
using pg8::Unit;

typedef f32x4 Acc[2][2][4][2];
__device__ __forceinline__ float red_fq(float s) {
    s += __int_as_float(__builtin_amdgcn_ds_swizzle(__float_as_int(s), 0x401F));
    auto rr = __builtin_amdgcn_permlane32_swap(__float_as_uint(s), __float_as_uint(s), false, false);
    return __uint_as_float(rr[0]) + __uint_as_float(rr[1]);
}
__device__ __forceinline__ float ss4(f32x4 a) { return (a[0] * a[0] + a[1] * a[1]) + (a[2] * a[2] + a[3] * a[3]); }
__device__ __forceinline__ u32x4 pack8(f32x4 a, f32x4 b) { u32x4 w; w.x = pg8::cvt_pk_bf16(a[0], a[1]); w.y = pg8::cvt_pk_bf16(a[2], a[3]); w.z = pg8::cvt_pk_bf16(b[0], b[1]); w.w = pg8::cvt_pk_bf16(b[2], b[3]); return w; }
__device__ __forceinline__ f32x4 ld4(const float* p) { return *(const f32x4*)p; }
__device__ __forceinline__ float logsig(float z) { return fminf(z, 0.f) - log1pf(expf(-fabsf(z))); }

struct EpiFoxIn {
    static constexpr bool PERM = true;
    bf16 *Q, *QM; size_t qkv_stride; float *qss, *kss, *mqss, *logf;
    const float *gq, *gk, *gmq, *gmk, *bfg; const LAS float* rtab; int rbase;
    __device__ __forceinline__ void operator()(const Acc& acc, const Unit& u, int wr, int wc, int fr, int fq) const {
        const int pn = u.pn, rowb = u.pm * 256 + wr * 64 + fr, cw = wc * 32 + 8 * fq;
        if (pn < 36) {
            const int sec = pn / 12, hp = pn - sec * 12;
            bf16* base = Q + (size_t)sec * qkv_stride; float* ssb = sec ? kss : qss;
            f32x4 g0 = (f32x4){1.f, 1.f, 1.f, 1.f}, g1 = g0;
            if (sec == 0) { g0 = ld4(gq + cw) * ld4(gk + cw); g1 = ld4(gq + cw + 4) * ld4(gk + cw + 4); }
#pragma unroll
            for (int ai = 0; ai < 2; ++ai)
#pragma unroll
                for (int m = 0; m < 4; ++m) { const int row = rowb + ai * 128 + m * 16; const float rs = rtab[row - rbase];
#pragma unroll
                    for (int bj = 0; bj < 2; ++bj) { const int head = 2 * hp + bj; f32x4 v0 = acc[ai][bj][m][0] * rs, v1 = acc[ai][bj][m][1] * rs;
                        if (sec < 2) { const float s = red_fq(ss4(v0) + ss4(v1)); if (fq == 0) ssb[((size_t)row * NH + head) * 4 + wc] = s; }
                        if (sec == 0) { v0 = v0 * g0; v1 = v1 * g1; }
                        *(u32x4*)(base + ((size_t)head * T + row) * 128 + cw) = pack8(v0, v1); } }
        } else if (pn < 40) {
            const int mh = pn - 36; f32x4 g[2][2];
#pragma unroll
            for (int bj = 0; bj < 2; ++bj) { const int d = 128 * bj + cw; g[bj][0] = ld4(gmq + d) * ld4(gmk + d); g[bj][1] = ld4(gmq + d + 4) * ld4(gmk + d + 4); }
#pragma unroll
            for (int ai = 0; ai < 2; ++ai)
#pragma unroll
                for (int m = 0; m < 4; ++m) { const int row = rowb + ai * 128 + m * 16; const float rs = rtab[row - rbase];
                    f32x4 v[2][2]; float s = 0.f;
#pragma unroll
                    for (int bj = 0; bj < 2; ++bj) { v[bj][0] = acc[ai][bj][m][0] * rs; v[bj][1] = acc[ai][bj][m][1] * rs; s += ss4(v[bj][0]) + ss4(v[bj][1]); }
                    s = red_fq(s); if (fq == 0) mqss[((size_t)row * NMH + mh) * 4 + wc] = s;
#pragma unroll
                    for (int bj = 0; bj < 2; ++bj) *(u32x4*)(QM + ((size_t)mh * T + row) * 256 + 128 * bj + cw) = pack8(v[bj][0] * g[bj][0], v[bj][1] * g[bj][1]); }
        } else {
            if (wc == 0 && fq < 3) {
                const f32x4 b0 = ld4(bfg + 8 * fq), b1 = ld4(bfg + 8 * fq + 4);
#pragma unroll
                for (int ai = 0; ai < 2; ++ai)
#pragma unroll
                    for (int m = 0; m < 4; ++m) { const int row = rowb + ai * 128 + m * 16; const float rs = rtab[row - rbase];
                        const f32x4 v0 = acc[ai][0][m][0] * rs + b0, v1 = acc[ai][0][m][1] * rs + b1;
                        float* lp = logf + ((size_t)(row >> 12) * NH + 8 * fq) * SEQ + (row & (SEQ - 1));
#pragma unroll
                        for (int e = 0; e < 4; ++e) { lp[(size_t)e * SEQ] = logsig(v0[e]); lp[(size_t)(e + 4) * SEQ] = logsig(v1[e]); } }
            }
        }
    }
};
__device__ __forceinline__ void rope8(f32x4& v0, f32x4& v1, const f32x4 g1, const f32x4 g2, const f32x4 cs, const f32x4 sn) {
    const f32x4 x1 = v0 * g1, x2 = v1 * g2; v0 = x1 * cs - x2 * sn; v1 = x2 * cs + x1 * sn;
}
struct EpiMlaIn {
    static constexpr bool PERM = true;
    bf16 *CQ, *CKV, *QM, *RK; float *cqss, *ckvss, *mqss, *krss;
    const float *gmq, *gmk, *gkn  , *cosT, *sinT; const LAS float* rtab; int rbase;
    __device__ __forceinline__ void operator()(const Acc& acc, const Unit& u, int wr, int wc, int fr, int fq) const {
        const int pn = u.pn, rowb = u.pm * 256 + wr * 64 + fr, cw = wc * 32 + 8 * fq;
        if (pn < 8) {
            const bool isq = pn < 6; bf16* base = isq ? CQ : CKV; const int ld = isq ? QLR : KVLR, cb = isq ? pn * 256 : (pn - 6) * 256;
            float* ssb = isq ? cqss + pn * 4 + wc : ckvss + (pn - 6) * 4 + wc; const int sst = isq ? 24 : 8;
#pragma unroll
            for (int ai = 0; ai < 2; ++ai)
#pragma unroll
                for (int m = 0; m < 4; ++m) { const int row = rowb + ai * 128 + m * 16; const float rs = rtab[row - rbase];
                    f32x4 v[2][2]; float s = 0.f;
#pragma unroll
                    for (int bj = 0; bj < 2; ++bj) { v[bj][0] = acc[ai][bj][m][0] * rs; v[bj][1] = acc[ai][bj][m][1] * rs; s += ss4(v[bj][0]) + ss4(v[bj][1]); }
                    s = red_fq(s); if (fq == 0) ssb[(size_t)row * sst] = s;
#pragma unroll
                    for (int bj = 0; bj < 2; ++bj) *(u32x4*)(base + act_off(row, cb + 128 * bj + cw, T, ld)) = pack8(v[bj][0], v[bj][1]); }
        } else if (pn < 12) {
            const int mh = pn - 8; f32x4 g[2][2];
#pragma unroll
            for (int bj = 0; bj < 2; ++bj) { const int d = 128 * bj + cw; g[bj][0] = ld4(gmq + d) * ld4(gmk + d); g[bj][1] = ld4(gmq + d + 4) * ld4(gmk + d + 4); }
#pragma unroll
            for (int ai = 0; ai < 2; ++ai)
#pragma unroll
                for (int m = 0; m < 4; ++m) { const int row = rowb + ai * 128 + m * 16; const float rs = rtab[row - rbase];
                    f32x4 v[2][2]; float s = 0.f;
#pragma unroll
                    for (int bj = 0; bj < 2; ++bj) { v[bj][0] = acc[ai][bj][m][0] * rs; v[bj][1] = acc[ai][bj][m][1] * rs; s += ss4(v[bj][0]) + ss4(v[bj][1]); }
                    s = red_fq(s); if (fq == 0) mqss[((size_t)row * NMH + mh) * 4 + wc] = s;
#pragma unroll
                    for (int bj = 0; bj < 2; ++bj) *(u32x4*)(QM + ((size_t)mh * T + row) * 256 + 128 * bj + cw) = pack8(v[bj][0] * g[bj][0], v[bj][1] * g[bj][1]); }
        } else {
            if (wc < 2) {
                const int i0 = 16 * wc + 4 * fq; const f32x4 g1 = ld4(gkn + 128 + i0), g2 = ld4(gkn + 160 + i0);
#pragma unroll
                for (int ai = 0; ai < 2; ++ai)
#pragma unroll
                    for (int m = 0; m < 4; ++m) { const int row = rowb + ai * 128 + m * 16; const float rs = rtab[row - rbase];
                        f32x4 v0 = acc[ai][0][m][0] * rs, v1 = acc[ai][0][m][1] * rs;
                        const float s = red_fq(ss4(v0) + ss4(v1)); if (fq == 0) krss[(size_t)row * 2 + wc] = s;
                        rope8(v0, v1, g1, g2, ld4(cosT + (size_t)row * 32 + i0), ld4(sinT + (size_t)row * 32 + i0));
                        *(u32x4*)(RK + (size_t)row * 64 + 32 * wc + 8 * fq) = pack8(v0, v1); }
            }
        }
    }
};
struct EpiQB {
    static constexpr bool PERM = true;
    bf16 *QN, *QR; float* qss; const float *gq, *gk, *cosT, *sinT; const LAS float* rtab; int rbase;
    __device__ __forceinline__ void operator()(const Acc& acc, const Unit& u, int wr, int wc, int fr, int fq) const {
        const int pn = u.pn, rowb = u.pm * 256 + wr * 64 + fr, cw = wc * 32 + 8 * fq;
        if (pn < 12) {
            const f32x4 g0 = ld4(gq + cw) * ld4(gk + cw), g1 = ld4(gq + cw + 4) * ld4(gk + cw + 4);
#pragma unroll
            for (int ai = 0; ai < 2; ++ai)
#pragma unroll
                for (int m = 0; m < 4; ++m) { const int row = rowb + ai * 128 + m * 16; const float rs = rtab[row - rbase];
#pragma unroll
                    for (int bj = 0; bj < 2; ++bj) { const int head = 2 * pn + bj; const f32x4 v0 = acc[ai][bj][m][0] * rs, v1 = acc[ai][bj][m][1] * rs;
                        const float s = red_fq(ss4(v0) + ss4(v1)); if (fq == 0) qss[((size_t)row * NH + head) * 8 + wc] = s;
                        *(u32x4*)(QN + ((size_t)head * T + row) * 128 + cw) = pack8(v0 * g0, v1 * g1); } }
        } else {
            const int t = pn - 12, wl = wc & 1, i0 = 16 * wl + 4 * fq; const f32x4 g1 = ld4(gq + 128 + i0), g2 = ld4(gq + 160 + i0);
#pragma unroll
            for (int ai = 0; ai < 2; ++ai)
#pragma unroll
                for (int m = 0; m < 4; ++m) { const int row = rowb + ai * 128 + m * 16; const float rs = rtab[row - rbase];
                    const f32x4 cs = ld4(cosT + (size_t)row * 32 + i0), sn = ld4(sinT + (size_t)row * 32 + i0);
#pragma unroll
                    for (int bj = 0; bj < 2; ++bj) { const int head = 4 * t + 2 * bj + (wc >> 1); f32x4 v0 = acc[ai][bj][m][0] * rs, v1 = acc[ai][bj][m][1] * rs;
                        const float s = red_fq(ss4(v0) + ss4(v1)); if (fq == 0) qss[((size_t)row * NH + head) * 8 + 4 + wl] = s;
                        rope8(v0, v1, g1, g2, cs, sn);
                        *(u32x4*)(QR + ((size_t)head * T + row) * 64 + 32 * wl + 8 * fq) = pack8(v0, v1); } }
        }
    }
};
struct EpiKVB {
    static constexpr bool PERM = true;
    bf16 *KN, *VV; float* kss; const LAS float* rtab; int rbase;
    __device__ __forceinline__ void operator()(const Acc& acc, const Unit& u, int wr, int wc, int fr, int fq) const {
        const int pn = u.pn, rowb = u.pm * 256 + wr * 64 + fr, cw = wc * 32 + 8 * fq; const bool isk = pn < 12; const int hp = isk ? pn : pn - 12; bf16* base = isk ? KN : VV;
#pragma unroll
        for (int ai = 0; ai < 2; ++ai)
#pragma unroll
            for (int m = 0; m < 4; ++m) { const int row = rowb + ai * 128 + m * 16; const float rs = rtab[row - rbase];
#pragma unroll
                for (int bj = 0; bj < 2; ++bj) { const int head = 2 * hp + bj; const f32x4 v0 = acc[ai][bj][m][0] * rs, v1 = acc[ai][bj][m][1] * rs;
                    if (isk) { const float s = red_fq(ss4(v0) + ss4(v1)); if (fq == 0) kss[((size_t)row * NH + head) * 4 + wc] = s; }
                    *(u32x4*)(base + ((size_t)head * T + row) * 128 + cw) = pack8(v0, v1); } }
    }
};
struct EpiMemKV {
    static constexpr bool PERM = true;
    bf16 *MK, *MV; float* mkss; const LAS float* rtab; int rbase;
    __device__ __forceinline__ void operator()(const Acc& acc, const Unit& u, int wr, int wc, int fr, int fq) const {
        const int pn = u.pn, rowb = u.pm * 256 + wr * 64 + fr, cw = wc * 32 + 8 * fq; const bool isk = pn < 4; const int mh = isk ? pn : pn - 4; bf16* base = isk ? MK : MV;
#pragma unroll
        for (int ai = 0; ai < 2; ++ai)
#pragma unroll
            for (int m = 0; m < 4; ++m) { const int row = rowb + ai * 128 + m * 16; const float rs = rtab[row - rbase];
                f32x4 v[2][2]; float s = 0.f;
#pragma unroll
                for (int bj = 0; bj < 2; ++bj) { v[bj][0] = acc[ai][bj][m][0] * rs; v[bj][1] = acc[ai][bj][m][1] * rs; s += ss4(v[bj][0]) + ss4(v[bj][1]); }
                if (isk) { s = red_fq(s); if (fq == 0) mkss[((size_t)mh * MT + row) * 4 + wc] = s; }
#pragma unroll
                for (int bj = 0; bj < 2; ++bj) *(u32x4*)(base + (size_t)row * 1024 + mh * 256 + 128 * bj + cw) = pack8(v[bj][0], v[bj][1]); }
    }
};
__device__ __forceinline__ f32x4 bf2f_lo(u32x2 w) { return (f32x4){__uint_as_float(w.x << 16), __uint_as_float(w.x & 0xffff0000u), __uint_as_float(w.y << 16), __uint_as_float(w.y & 0xffff0000u)}; }
template <bool LAST> struct EpiRes {
    static constexpr bool PERM = true;
    const bf16* XBr; bf16* XB; float* out; float* rss;
    __device__ __forceinline__ void operator()(const Acc& acc, const Unit& u, int wr, int wc, int fr, int fq) const {
        const int pn = u.pn, rowb = u.pm * 256 + wr * 64 + fr, cw = wc * 32 + 8 * fq;
#pragma unroll
        for (int ai = 0; ai < 2; ++ai)
#pragma unroll
            for (int m = 0; m < 4; ++m) { const int row = rowb + ai * 128 + m * 16; float s = 0.f;
#pragma unroll
                for (int bj = 0; bj < 2; ++bj) { const size_t o = (size_t)row * DM + pn * 256 + 128 * bj + cw, ob = act_off(row, pn * 256 + 128 * bj + cw, T, DM);
                    const u32x4 xr = *(const u32x4*)(XBr + ob);
                    const f32x4 v0 = bf2f_lo((u32x2){xr.x, xr.y}) + acc[ai][bj][m][0], v1 = bf2f_lo((u32x2){xr.z, xr.w}) + acc[ai][bj][m][1];
                    if (LAST) { *(f32x4*)(out + o) = v0; *(f32x4*)(out + o + 4) = v1; }
                    else { s += ss4(v0) + ss4(v1); *(u32x4*)(XB + ob) = pack8(v0, v1); } }
                if (!LAST) { s = red_fq(s); if (fq == 0) rss[(size_t)row * 64 + pn * 4 + wc] = s; } }
    }
};
struct EpiUp {
    static constexpr bool PERM = true;
    bf16* HID; const LAS float* rtab; int rbase;
    __device__ __forceinline__ void operator()(const Acc& acc, const Unit& u, int wr, int wc, int fr, int fq) const {
        const int pn = u.pn, rowb = u.pm * 256 + wr * 64 + fr, cw = wc * 32 + 8 * fq;
#pragma unroll
        for (int ai = 0; ai < 2; ++ai)
#pragma unroll
            for (int m = 0; m < 4; ++m) { const int row = rowb + ai * 128 + m * 16; const float rs = rtab[row - rbase];
#pragma unroll
                for (int bj = 0; bj < 2; ++bj) { f32x4 v0 = acc[ai][bj][m][0] * rs, v1 = acc[ai][bj][m][1] * rs;
#pragma unroll
                    for (int e = 0; e < 4; ++e) { const float a = fmaxf(v0[e], 0.f), b = fmaxf(v1[e], 0.f); v0[e] = a * a; v1[e] = b * b; }
                    { const int col = pn * 256 + 128 * bj + cw;
                      *(u32x4*)(HID + (HID_BLK ? ((size_t)(col >> 6) * T + row) * 64 + (col & 63) : (size_t)row * FF + col)) = pack8(v0, v1); } } }
    }
};

namespace att {
constexpr int SHM_V = 64 * 128 * 2;
constexpr int L_V = 0, L_K = 49152, L_WS = 155648, L_SC = 157696;
constexpr int l_rk(int dk) { return L_K + 3 * 64 * dk * 2; }
constexpr int l_dl(int dk) { return l_rk(dk) + 16384; }
static_assert(l_dl(128) + 16384 <= L_WS && l_rk(192) + 16384 <= L_WS && l_rk(256) + 1024 <= L_WS, "attention LDS map");
__device__ __forceinline__ int v_st(int k, int c) { const int kk = (k & ~0xC) | ((k & 4) << 1) | ((k & 8) >> 1); return ((kk >> 3) * 4 + (c >> 5)) * 512 + ((kk & 7) * 32 + (c & 31)) * 2; }
__device__ __forceinline__ int v_rd_base(int lane) { return ((lane & 3) << 3) | (((lane >> 2) & 3) << 6) | (((lane >> 4) & 1) << 5) | (((lane >> 5) & 1) << 8); }
constexpr int v_rd_off(int d0, int ks, int half) { return d0 * 512 + ks * 4096 + half * 2048; }
__device__ __forceinline__ int crow(int r, int hi) { return (r & 3) + 8 * (r >> 2) + 4 * hi; }
__device__ __forceinline__ unsigned cvtpk(float lo, float hi) { return pg8::cvt_pk_bf16(lo, hi); }
#define SBAR() __builtin_amdgcn_sched_barrier(0)
__device__ __forceinline__ float fmul_s(float a, float b) { return a * b; }
__device__ __forceinline__ float fadd_s(float a, float b) { return a + b; }
__device__ __forceinline__ float fsub_s(float a, float b) { return a - b; }
__device__ __forceinline__ float ffma_s(float a, float b, float c) { return __builtin_fmaf(a, b, c); }

struct Blk {
    const bf16 *Qa, *Qb;
    const bf16 *Ka, *Kb;
    const bf16* V;
    bf16* O; int orow0, ocol0;
    const float* qssp;
    int nkt;
    int nrun;
    int qpos0;
};
template <int QPA, int QPB, int KPA, int KPB, int VP, int QSTR> struct Pitch { static constexpr int qpa = QPA, qpb = QPB, kpa = KPA, kpb = KPB, vp = VP, qstr = QSTR; };

template <int DK, int DKA, int NQS, bool CAUSAL, bool BIAS, bool QREG, bool REV, class P>
__device__ __forceinline__ void attn_block(char* lds, const Blk& B, const int wv) {
    constexpr int SWA = (DKA == 128) ? 15 : 7, NKBP = (SWA + 1) / 2;
    constexpr int RSA = DKA * 2, RSB = 128, SHM_K = 64 * DK * 2, KB_OFF = 64 * RSA, NPA = DKA / 64, ND = DK / 16, NDA = DKA / 16; constexpr bool HASB = DK > DKA;
    constexpr int NP = NPA + (HASB ? 1 : 0) + 2;
    static_assert(!HASB || DK - DKA == 64, "region B is 64 dims");
    int tid = tid_of(wv); asm volatile("" : "+v"(tid));
    const int wid = __builtin_amdgcn_readfirstlane(tid >> 6), lane = tid & 63, r32 = lane & 31, hi = lane >> 5, grp = wid >> 2;
    LAS unsigned char* ldsl = (LAS unsigned char*)lds;
    char* V_lds = lds + L_V; char* K_lds = lds + L_K;
    const float* DL = (const float*)(lds + l_dl(DK)); const float* RKt = (const float*)(lds + l_rk(DK));
    const int qrow = wid * 32 + r32;
    const unsigned qoa = (unsigned)(qrow * P::qpa + hi * 8) * 2u, qob = (unsigned)(qrow * P::qpb + hi * 8) * 2u;
#define QFRAG(d0) ((d0) < NDA ? *(const bf16x8*)((const char*)B.Qa + (qoa + (d0) * 32)) : *(const bf16x8*)((const char*)B.Qb + (qob + ((d0) - NDA) * 32)))
    float rq;
    { const float* qp = B.qssp + (size_t)qrow * P::qstr; const f32x4 a = ld4(qp); float s = (a[0] + a[1]) + (a[2] + a[3]);
      if (NQS == 6) { const f32x2 b = *(const f32x2*)(qp + 4); s += b[0] + b[1]; }
      rq = rsqrtf(s * (1.f / DK) + EPS); }
    bf16x8 qr[QREG ? ND : 1];
    if (QREG) {
#pragma unroll
        for (int d0 = 0; d0 < ND; ++d0) { const bf16x8 raw = QFRAG(d0); const u32x4 w = *reinterpret_cast<const u32x4*>(&raw); u32x4 o_;
#pragma unroll
            for (int e = 0; e < 4; ++e) o_[e] = cvtpk(__uint_as_float(w[e] << 16) * rq, __uint_as_float(w[e] & 0xffff0000u) * rq);
            qr[QREG ? d0 : 0] = *reinterpret_cast<const bf16x8*>(&o_); } }
    const float rqs = QREG ? 1.f : rq;
    const int qlo = B.qpos0 + wid * 32, qpos = qlo + r32;
    constexpr int NKA = 2 * NPA, NKB = HASB ? 2 : 0, NK_ = NKA + NKB, NVP = 4;
    const int lw = wid & 3;
    static_assert((4096 / RSA) % (SWA + 1) == 0 && (4096 / RSB) % 8 == 0, "piece stride keeps the swizzle phase");
    unsigned kva0, kvb0 = 0u, vva0;
    { const int b = lw * 1024 + lane * 16, krow = b / RSA, x = b % RSA, kc = (x ^ ((krow & SWA) << 4)) >> 4; kva0 = (unsigned)(krow * P::kpa + kc * 8) * 2u; }
    if (HASB) { const int b = lw * 1024 + lane * 16, krow = b / RSB, x = b % RSB, kc = (x ^ ((krow & 7) << 4)) >> 4; kvb0 = (unsigned)(krow * P::kpb + kc * 8) * 2u; }
    { const int b = lw * 1024 + lane * 16, sub = b >> 9, w = (b & 511) >> 1, kk = (sub >> 2) * 8 + (w >> 5), c = (sub & 3) * 32 + (w & 31);
      const int k = (kk & ~0xC) | ((kk & 4) << 1) | ((kk & 8) >> 1); vva0 = (unsigned)(k * P::vp + c) * 2u; }
    constexpr unsigned PSA = (unsigned)((4096 / RSA) * P::kpa) * 2u, PSB = (unsigned)((4096 / RSB) * P::kpb) * 2u, PSV = (unsigned)(16 * P::vp) * 2u;
    const unsigned tsa = (unsigned)(64 * P::kpa) * 2u, tsb = (unsigned)(64 * P::kpb) * 2u, tsv = (unsigned)(64 * P::vp) * 2u;
    const int vb0 = (int)(uintptr_t)V_lds + v_rd_base(lane);
#define DMA16(gp, ldsoff) __builtin_amdgcn_global_load_lds((const unsigned*)(gp), (LAS unsigned*)(ldsl + (ldsoff)), 16, 0, 0)
#define LOADK(t_, bf) do { _Pragma("unroll") for (int i = 0; i < NKA; ++i) DMA16((const char*)B.Ka + ((size_t)(unsigned)(t_) * tsa + i * PSA) + kva0, L_K + (bf) * SHM_K + (lw + 4 * i) * 1024); \
        if (HASB) { _Pragma("unroll") for (int i = 0; i < 2; ++i) DMA16((const char*)B.Kb + ((size_t)(unsigned)(t_) * tsb + i * PSB) + kvb0, L_K + (bf) * SHM_K + KB_OFF + (lw + 4 * i) * 1024); } } while (0)
#define LOADV(t_, bf) do { _Pragma("unroll") for (int i = 0; i < NVP; ++i) DMA16((const char*)B.V + ((size_t)(unsigned)(t_) * tsv + i * PSV) + vva0, L_V + (bf) * SHM_V + (lw + 4 * i) * 1024); } while (0)
#define VMWAIT(n) asm volatile("s_waitcnt vmcnt(%0)" :: "n"(n) : "memory")
#define WGBAR() do { asm volatile("" ::: "memory"); __builtin_amdgcn_s_barrier(); asm volatile("" ::: "memory"); } while (0)
    constexpr float DEFER_THR = 8.f;
    float m_reg = 0.f, l_reg = 0.f; f32x16 o[4] = {};
    const int nkt = B.nkt, nrun = B.nrun;
#define KT(t_) (REV ? nkt - 1 - (t_) : (t_))
    if (!grp) { LOADK(KT(0), 0); LOADV(KT(0), 0); LOADK(KT(1), 1); LOADV(KT(1), 1); VMWAIT(NVP + NK_ + NVP); }
    WGBAR();
    if (grp) WGBAR();
#define SCALE(P, kk_) do { _Pragma("unroll") for (int g = 0; g < 4; ++g) { \
            f32x4 rk_ = ld4(RKt + (kk_) + 8 * g); if (!QREG) { _Pragma("unroll") for (int j = 0; j < 4; ++j) rk_[j] = fmul_s(rk_[j], rqs); } \
            if (BIAS) { const f32x4 nd_ = ld4(DL + (kk_) + 8 * g) - m_reg; \
                _Pragma("unroll") for (int j = 0; j < 4; ++j) P[4 * g + j] = ffma_s(P[4 * g + j], rk_[j], nd_[j]); } \
            else { const float nm_ = -m_reg; _Pragma("unroll") for (int j = 0; j < 4; ++j) P[4 * g + j] = ffma_s(P[4 * g + j], rk_[j], nm_); } } } while (0)
#define MASK1(P, r_, c_) asm volatile("v_cmp_lt_i32 vcc, %1, %2\n\tv_cndmask_b32 %0, %0, %3, vcc" : "+v"(P[r_]) : "v"(dqk), "n"(c_), "v"(NEG) : "vcc")
#define TRRD(dst, off) asm volatile("ds_read_b64_tr_b16 %0, %1 offset:%2" : "=&v"(dst) : "v"(vb0), "i"(off) : "memory")
#define LGK(n) do { asm volatile("s_waitcnt lgkmcnt(" #n ")" ::: "memory"); SBAR(); } while (0)
#define VLD(S, VB, ks) do { constexpr int b_ = (VB) * SHM_V + (ks) * 4096; \
        TRRD(S##l0, b_); TRRD(S##h0, b_ + 2048); TRRD(S##l1, b_ + 512); TRRD(S##h1, b_ + 2560); TRRD(S##l2, b_ + 1024); TRRD(S##h2, b_ + 3072); TRRD(S##l3, b_ + 1536); TRRD(S##h3, b_ + 3584); } while (0)
#define MM(S, d0, PA) o[d0] = __builtin_amdgcn_mfma_f32_32x32x16_bf16((bf16x8){S##l##d0[0], S##l##d0[1], S##l##d0[2], S##l##d0[3], S##h##d0[0], S##h##d0[1], S##h##d0[2], S##h##d0[3]}, PA, o[d0], 0, 0, 0)
#define EXS(P, B_, j, CV) do { P[B_ + 2 * (j)] = __builtin_amdgcn_exp2f(P[B_ + 2 * (j)]); P[B_ + 2 * (j) + 1] = __builtin_amdgcn_exp2f(P[B_ + 2 * (j) + 1]); \
        ps += P[B_ + 2 * (j)] + P[B_ + 2 * (j) + 1]; CV = cvtpk(P[B_ + 2 * (j)], P[B_ + 2 * (j) + 1]); } while (0)
#define PKQ(OUT) do { auto r0 = __builtin_amdgcn_permlane32_swap(a0, b0, false, false); auto r1 = __builtin_amdgcn_permlane32_swap(a1, b1, false, false); \
        u32x4 w = {r0[0], r1[0], r0[1], r1[1]}; OUT = *reinterpret_cast<bf16x8*>(&w); } while (0)
#define EXP2(P, i0) do { P[i0] = __builtin_amdgcn_exp2f(P[i0]); P[(i0) + 1] = __builtin_amdgcn_exp2f(P[(i0) + 1]); } while (0)
#define ACC2(P, i0, CV) do { ps += P[i0]; ps += P[(i0) + 1]; CV = cvtpk(P[i0], P[(i0) + 1]); } while (0)
#define QBODY(S, PA, P, B_) \
        MM(S, 0, PA); EXP2(P, B_); SBAR(); \
        MM(S, 1, PA); EXP2(P, B_ + 2); ACC2(P, B_, a0); SBAR(); \
        MM(S, 2, PA); EXP2(P, B_ + 4); ACC2(P, B_ + 2, a1); SBAR(); \
        MM(S, 3, PA); EXP2(P, B_ + 6); ACC2(P, B_ + 4, b0); SBAR()
#define QTAIL(P, B_, OUT) do { ACC2(P, B_ + 6, b1); PKQ(OUT); SBAR(); } while (0)
#define KFR(BUF, i_, h_) (*reinterpret_cast<const bf16x8*>((i_) < NDA ? kbp[(i_) % NKBP] + ((i_) / NKBP) * (NKBP * 32) + (h_) * 32 * RSA \
        : K_lds + (BUF) * SHM_K + KB_OFF + (r32 + (h_) * 32) * RSB + (((((i_) - NDA) * 16 + hi * 8) * 2) ^ ((r32 & 7) << 4))))
#define SCALE2(P, RK_, DL_) do { _Pragma("unroll") for (int g = 0; g < 4; ++g) { \
            if (BIAS) { const f32x4 nd_ = DL_[g] - m_reg; _Pragma("unroll") for (int j = 0; j < 4; ++j) P[4 * g + j] = ffma_s(P[4 * g + j], RK_[g][j], nd_[j]); } \
            else { const float nm_ = -m_reg; _Pragma("unroll") for (int j = 0; j < 4; ++j) P[4 * g + j] = ffma_s(P[4 * g + j], RK_[g][j], nm_); } } } while (0)
#define STEP(BUF, t_) do { const int kb_ = KT(t_) * 64; \
        const bool act_ = !(CAUSAL && kb_ > qlo + 31);        \
          \
          \
        bf16x8 qt[QREG ? 1 : ND]; if (!QREG) { _Pragma("unroll") for (int d0 = 0; d0 < ND; ++d0) qt[QREG ? 0 : d0] = QFRAG(d0); asm volatile("" :: "v"(qt[QREG ? 0 : ND - 1]) : "memory"); }     \
        if (!grp && (t_) + 2 < nrun) LOADK(KT((t_) + 2), ((BUF) + 2) % 3); \
        f32x16 p0 = {}, p1 = {}; SBAR(); \
        if (act_) { const char* kbp[NKBP]; _Pragma("unroll") for (int dd = 0; dd < NKBP; ++dd) kbp[dd] = K_lds + (BUF) * SHM_K + r32 * RSA + (((dd * 16 + hi * 8) * 2) ^ ((r32 & SWA) << 4)); \
          if constexpr (QREG) { \
            \
            \
            \
          constexpr int RD = 8; \
          bf16x8 ka_[RD], kb2_[RD]; f32x4 rkA[4], rkB[4], dlA[4] = {}, dlB[4] = {}; const int kk0_ = kb_ + 4 * hi; \
          _Pragma("unroll") for (int s_ = 0; s_ < RD; ++s_) { ka_[s_] = KFR(BUF, s_, 0); kb2_[s_] = KFR(BUF, s_, 1); } \
          SBAR(); \
          _Pragma("unroll") for (int d0 = 0; d0 < ND; ++d0) { \
            p0 = __builtin_amdgcn_mfma_f32_32x32x16_bf16(ka_[d0 % RD], qr[QREG ? d0 : 0], p0, 0, 0, 0); p1 = __builtin_amdgcn_mfma_f32_32x32x16_bf16(kb2_[d0 % RD], qr[QREG ? d0 : 0], p1, 0, 0, 0); \
            if (d0 + RD < ND) { ka_[d0 % RD] = KFR(BUF, d0 + RD, 0); kb2_[d0 % RD] = KFR(BUF, d0 + RD, 1); } \
            if (d0 == ND - 4) { _Pragma("unroll") for (int g = 0; g < 4; ++g) { rkA[g] = ld4(RKt + kk0_ + 8 * g); if (BIAS) dlA[g] = ld4(DL + kk0_ + 8 * g); } } \
            if (d0 == ND - 2) { _Pragma("unroll") for (int g = 0; g < 4; ++g) { rkB[g] = ld4(RKt + kk0_ + 32 + 8 * g); if (BIAS) dlB[g] = ld4(DL + kk0_ + 32 + 8 * g); } } \
            SBAR(); } \
          SCALE2(p0, rkA, dlA); SCALE2(p1, rkB, dlB); \
          } else { \
          _Pragma("unroll") for (int d0 = 0; d0 < NDA; ++d0) { const char* a_ = kbp[d0 % NKBP] + (d0 / NKBP) * (NKBP * 32); \
            const bf16x8 b0_ = *reinterpret_cast<const bf16x8*>(a_), b1_ = *reinterpret_cast<const bf16x8*>(a_ + 32 * RSA); \
            const bf16x8 q_ = QREG ? qr[QREG ? d0 : 0] : qt[QREG ? 0 : d0]; \
            p0 = __builtin_amdgcn_mfma_f32_32x32x16_bf16(b0_, q_, p0, 0, 0, 0); p1 = __builtin_amdgcn_mfma_f32_32x32x16_bf16(b1_, q_, p1, 0, 0, 0); if (!QREG && (d0 & 3) == 3) SBAR(); } \
          if (HASB) { _Pragma("unroll") for (int e = 0; e < 4; ++e) { const char* a_ = K_lds + (BUF) * SHM_K + KB_OFF + r32 * RSB + (((e * 16 + hi * 8) * 2) ^ ((r32 & 7) << 4)); \
            const bf16x8 b0_ = *reinterpret_cast<const bf16x8*>(a_), b1_ = *reinterpret_cast<const bf16x8*>(a_ + 32 * RSB); \
            const bf16x8 q_ = QREG ? qr[QREG ? NDA + e : 0] : qt[QREG ? 0 : NDA + e]; \
            p0 = __builtin_amdgcn_mfma_f32_32x32x16_bf16(b0_, q_, p0, 0, 0, 0); p1 = __builtin_amdgcn_mfma_f32_32x32x16_bf16(b1_, q_, p1, 0, 0, 0); } } \
        SBAR(); SCALE(p0, kb_ + 4 * hi); SCALE(p1, kb_ + 32 + 4 * hi); } } SBAR(); \
        if (!grp) { if ((t_) + 2 < nrun) VMWAIT(2 * NK_ + NVP); else if ((t_) + 1 < nrun) VMWAIT(NK_ + NVP); else VMWAIT(0); }     \
        WGBAR(); \
          \
        if (!grp && (t_) + 2 < nrun) LOADV(KT((t_) + 2), ((BUF) + 2) % 3); \
        if (act_) { \
        if (CAUSAL && kb_ + 63 > qlo) { const float NEG = -__builtin_inff(); const int dqk = qpos - kb_ - 4 * hi; \
            _Pragma("unroll") for (int r = 0; r < 16; ++r) { MASK1(p0, r, (r & 3) + 8 * (r >> 2)); MASK1(p1, r, (r & 3) + 8 * (r >> 2) + 32); } } \
        float pmax = fmaxf(fmaxf(p0[0], p0[1]), p1[0]); \
        _Pragma("unroll") for (int r = 2; r < 16; r += 2) pmax = fmaxf(fmaxf(pmax, p0[r]), p0[r + 1]); \
        _Pragma("unroll") for (int r = 1; r < 15; r += 2) pmax = fmaxf(fmaxf(pmax, p1[r]), p1[r + 1]); \
        pmax = fmaxf(pmax, p1[15]); \
        { auto rr = __builtin_amdgcn_permlane32_swap(__float_as_uint(pmax), __float_as_uint(pmax), false, false); pmax = fmaxf(__uint_as_float(rr[0]), __uint_as_float(rr[1])); } \
          \
          \
        if (!__all(pmax <= DEFER_THR)) { const float dl_ = fmaxf(pmax, 0.f); const float alpha = __builtin_amdgcn_exp2f(-dl_); m_reg += dl_; l_reg *= alpha; \
            _Pragma("unroll") for (int r = 0; r < 16; ++r) { p0[r] = fsub_s(p0[r], dl_); p1[r] = fsub_s(p1[r], dl_); } \
            _Pragma("unroll") for (int d_ = 0; d_ < 4; ++d_) _Pragma("unroll") for (int r = 0; r < 16; ++r) o[d_][r] = fmul_s(o[d_][r], alpha); } \
          \
          \
        float ps = 0.f; bf16x8 pa0, pa1, pa2, pa3; \
        s16x4 Al0, Al1, Al2, Al3, Ah0, Ah1, Ah2, Ah3, Bl0, Bl1, Bl2, Bl3, Bh0, Bh1, Bh2, Bh3; \
        SBAR(); asm volatile("s_waitcnt lgkmcnt(0)" ::: "memory");     \
        VLD(A, BUF, 0); SBAR(); \
        { unsigned a0, a1, b0, b1; EXS(p0, 0, 0, a0); EXS(p0, 0, 1, a1); EXS(p0, 0, 2, b0); EXS(p0, 0, 3, b1); PKQ(pa0); } SBAR(); \
        VLD(B, BUF, 1); LGK(8); \
        { unsigned a0, a1, b0, b1; QBODY(A, pa0, p0, 8); VLD(A, BUF, 2); SBAR(); QTAIL(p0, 8, pa1); } LGK(8); \
        { unsigned a0, a1, b0, b1; QBODY(B, pa1, p1, 0); VLD(B, BUF, 3); SBAR(); QTAIL(p1, 0, pa2); } LGK(8); \
        { unsigned a0, a1, b0, b1; QBODY(A, pa2, p1, 8); SBAR(); QTAIL(p1, 8, pa3); } \
        LGK(0); MM(B, 0, pa3); MM(B, 1, pa3); MM(B, 2, pa3); MM(B, 3, pa3); \
        { auto rr = __builtin_amdgcn_permlane32_swap(__float_as_uint(ps), __float_as_uint(ps), false, false); ps = __uint_as_float(rr[0]) + __uint_as_float(rr[1]); } \
        l_reg += ps; } SBAR(); \
        if (!grp) { if ((t_) + 2 < nrun) VMWAIT(NVP + NK_ + NVP); else if ((t_) + 1 < nrun) VMWAIT(NVP); else VMWAIT(0); }     \
        WGBAR(); } while (0)
#define PK4(P, B_, OUT) do { const unsigned a0 = cvtpk(P[B_ + 0], P[B_ + 1]), a1 = cvtpk(P[B_ + 2], P[B_ + 3]); \
        const unsigned b0 = cvtpk(P[B_ + 4], P[B_ + 5]), b1 = cvtpk(P[B_ + 6], P[B_ + 7]); \
        auto r0 = __builtin_amdgcn_permlane32_swap(a0, b0, false, false); auto r1 = __builtin_amdgcn_permlane32_swap(a1, b1, false, false); \
        u32x4 w = {r0[0], r1[0], r0[1], r1[1]}; OUT = *reinterpret_cast<bf16x8*>(&w); } while (0)
    for (int t = 0; t < nrun; t += 3) { STEP(0, t); if (t + 1 < nrun) STEP(1, t + 1); if (t + 2 < nrun) STEP(2, t + 2); }
    if (!grp) WGBAR();
#undef PK4
#undef STEP
#undef SCALE2
#undef KFR
#undef QTAIL
#undef QBODY
#undef ACC2
#undef EXP2
#undef PKQ
#undef EXS
#undef MM
#undef VLD
#undef LGK
#undef TRRD
#undef MASK1
#undef KT
#undef SCALE
#undef LOADV
#undef LOADK
#undef DMA16
#undef VMWAIT
#undef WGBAR
#undef QFRAG
    { const float rli = __builtin_amdgcn_rcpf(l_reg);
      int lane_e = lane; asm volatile("" : "+v"(lane_e));
      const int orow = B.orow0 + wid * 32 + (lane_e & 31), ocol = B.ocol0 + (lane_e >> 5) * 8;
#pragma unroll
      for (int d0 = 0; d0 < 4; ++d0)
#pragma unroll
          for (int g = 0; g < 4; g += 2) {
              unsigned ax = cvtpk(o[d0][4 * g] * rli, o[d0][4 * g + 1] * rli), ay = cvtpk(o[d0][4 * g + 2] * rli, o[d0][4 * g + 3] * rli);
              unsigned bx_ = cvtpk(o[d0][4 * g + 4] * rli, o[d0][4 * g + 5] * rli), by = cvtpk(o[d0][4 * g + 6] * rli, o[d0][4 * g + 7] * rli);
              { auto r = __builtin_amdgcn_permlane32_swap(ax, bx_, false, false); ax = r[0]; bx_ = r[1]; }
              { auto r = __builtin_amdgcn_permlane32_swap(ay, by, false, false); ay = r[0]; by = r[1]; }
              *(u32x4*)(B.O + act_off(orow, ocol + d0 * 32 + g * 8, T, DM)) = (u32x4){ax, ay, bx_, by}; } }
}

__device__ __forceinline__ void build_decay(char* lds, const float* lf, int n, const int wv) {
    int tid = tid_of(wv); asm volatile("" : "+v"(tid));
    const int wid = __builtin_amdgcn_readfirstlane(tid >> 6), lane = tid & 63;
    float* DL = (float*)(lds + l_dl(128)); float* scw = (float*)(lds + L_SC);
    float v[8]; const bool act = 8 * tid < n;
    { f32x4 a = act ? ld4(lf + 8 * tid) : (f32x4){0.f, 0.f, 0.f, 0.f}, b = act ? ld4(lf + 8 * tid + 4) : (f32x4){0.f, 0.f, 0.f, 0.f};
      v[0] = a[0]; v[1] = a[1]; v[2] = a[2]; v[3] = a[3]; v[4] = b[0]; v[5] = b[1]; v[6] = b[2]; v[7] = b[3]; }
#pragma unroll
    for (int e = 1; e < 8; ++e) v[e] += v[e - 1];
    const float tot = v[7]; float inc = tot;
#pragma unroll
    for (int o = 1; o < 64; o <<= 1) { const float y = __int_as_float(__builtin_amdgcn_ds_bpermute((lane - o) << 2, __float_as_int(inc))); if (lane >= o) inc += y; }
    if (lane == 63) scw[wid] = inc;
    __syncthreads();
    float base = inc - tot;
    for (int w = 0; w < wid; ++w) base += scw[w];
    if (act) {
#pragma unroll
        for (int e = 0; e < 8; ++e) DL[8 * tid + e] = -(base + v[e]) * LOG2E; }
}
}

constexpr size_t MiB = 1u << 20, KiB = 1u << 10;
constexpr size_t WS_CTL = 0, CTL_ZERO_BYTES = 1 * MiB;
constexpr size_t WS_RSTD0 = 1 * MiB;
constexpr size_t WS_RSTDM = WS_RSTD0 + 64 * KiB;
constexpr size_t WS_KRSS = WS_RSTDM + 64 * KiB;
constexpr size_t WS_MKSS = WS_KRSS + 128 * KiB;
constexpr size_t WS_CKVSS = WS_MKSS + 64 * KiB;
constexpr size_t WS_MQSS = WS_CKVSS + 512 * KiB;
constexpr size_t WS_CQSS = WS_MQSS + 1 * MiB;
constexpr size_t WS_LOGF = WS_CQSS + 1536 * KiB;
constexpr size_t WS_COS = WS_LOGF + 1536 * KiB;
constexpr size_t WS_SIN = WS_COS + 2 * MiB;
constexpr size_t WS_RSSA = WS_SIN + 2 * MiB;
constexpr size_t WS_RSSB = WS_RSSA + 4 * MiB;
constexpr size_t WS_KSS = WS_RSSB + 4 * MiB;
constexpr size_t WS_QSS = WS_KSS + 6 * MiB;
constexpr size_t WS_KSS1 = WS_QSS + 12 * MiB;
constexpr size_t WS_QSS1 = WS_KSS1 + 6 * MiB;
constexpr size_t WS_MQSS1 = WS_QSS1 + 12 * MiB;
constexpr size_t WS_SMALL_END = WS_MQSS1 + 1 * MiB;
static_assert(WS_SMALL_END <= 64 * MiB, "small arrays");
constexpr size_t WS_W_MEMKV = 64 * MiB;
constexpr size_t WS_W_FOXIN = WS_W_MEMKV + 16 * MiB;
constexpr size_t WS_W_O0 = WS_W_FOXIN + 82 * MiB, WS_W_O1 = WS_W_O0 + 32 * MiB;
constexpr size_t WS_W_UP0 = WS_W_O1 + 32 * MiB, WS_W_UP1 = WS_W_UP0 + 128 * MiB;
constexpr size_t WS_W_DN0 = WS_W_UP1 + 128 * MiB, WS_W_DN1 = WS_W_DN0 + 128 * MiB;
constexpr size_t WS_W_MLAIN = WS_W_DN1 + 128 * MiB;
constexpr size_t WS_W_QB = WS_W_MLAIN + 26 * MiB;
constexpr size_t WS_W_KVB = WS_W_QB + 14 * MiB;
constexpr size_t WS_XB = WS_W_KVB + 6 * MiB;
constexpr size_t WS_MEMN = WS_XB + 128 * MiB;
constexpr size_t WS_MK = WS_MEMN + 8 * MiB, WS_MV = WS_MK + 2 * MiB;
constexpr size_t WS_BIG = WS_MV + 2 * MiB;
constexpr size_t WS_HID = WS_BIG;
constexpr size_t WS_FQ = WS_BIG, WS_FK = WS_BIG + 96 * MiB, WS_FV = WS_BIG + 192 * MiB, WS_QM = WS_BIG + 288 * MiB, WS_MIX = WS_BIG + 320 * MiB;
constexpr size_t WS_CQ = WS_BIG, WS_CKV = WS_BIG + 48 * MiB, WS_RK = WS_BIG + 64 * MiB, WS_QM1 = WS_BIG + 68 * MiB, WS_QN = WS_BIG + 100 * MiB,
                 WS_QR = WS_BIG + 196 * MiB, WS_KN = WS_BIG + 244 * MiB, WS_VV = WS_BIG + 340 * MiB, WS_MIX1 = WS_BIG + 436 * MiB;
constexpr size_t WS_END = WS_BIG + 576 * MiB;
static_assert(WS_FV - WS_FK == WS_FK - WS_FQ, "Q | K | V equally spaced");
static_assert((size_t)FOXN * DM * 2 <= 82 * MiB && (size_t)MLAN * DM * 2 <= 26 * MiB && (size_t)QBN * QLR * 2 <= 14 * MiB, "weight slots");
constexpr int CW_BAR = 4096;

constexpr int RING_BYTES = 131072;
constexpr int L_TA = 135168, L_TB = 143360;
constexpr int MISC_OFF = 163328;
constexpr int LDS_BYTES = 163840;
constexpr int NWAVES = 8;
#ifndef ATT_MEM
#define ATT_MEM 1
#endif
#ifndef ATT_SELF
#define ATT_SELF 1
#endif
#ifndef PHASES
#define PHASES 0xFFF
#endif
#ifndef ATT_WRAP
#define ATT_WRAP 1
#endif
#ifndef REP_UP
#define REP_UP 1
#endif
#ifndef REP_WO
#define REP_WO 1
#endif
#ifndef REP_IN
#define REP_IN 1
#endif
#ifndef REP_DN
#define REP_DN 1
#endif
#ifndef W_BLK
#define W_BLK 1
#endif
#ifndef REP_P0
#define REP_P0 1
#endif
#ifndef REP_ATT
#define REP_ATT 1
#endif

#define XB_TMO      128
#define XB_XCNT(j)  (256  + 64 * (j))
#define XB_XSUB(j)  (1280 + 64 * (j))
#define XB_XGEN(j)  (2304 + 64 * (j))
#define XB_TOP      3328
#define XB_TOPGEN   3392
#define XCD_BAR_WORDS 3456
#define XB_SPIN_CAP (1u << 18)
__device__ __forceinline__ unsigned xb_ld(unsigned* p)              { return __hip_atomic_load(p, __ATOMIC_RELAXED, __HIP_MEMORY_SCOPE_AGENT); }
__device__ __forceinline__ unsigned xb_add(unsigned* p, unsigned v) { return __hip_atomic_fetch_add(p, v, __ATOMIC_RELAXED, __HIP_MEMORY_SCOPE_AGENT); }
__device__ __forceinline__ unsigned xb_xcc_id() { return (unsigned)__builtin_amdgcn_s_getreg((3 << 11) | 20) & 0xFu; }
#define XB_SPIN(cond, bar) do { unsigned _sp = 0; while (cond) { __builtin_amdgcn_s_sleep(1); \
    if ((++_sp & 255u) == 0u) { if (xb_ld(&(bar)[XB_TMO])) break; if (_sp > XB_SPIN_CAP) { atomicAdd(&(bar)[XB_TMO], 1u); break; } } } } while (0)
struct XcdBarrier { unsigned* bar; unsigned x; volatile LAS unsigned* st; };
__device__ __forceinline__ XcdBarrier xcd_barrier_post(unsigned* bar, volatile LAS unsigned* st) {
    XcdBarrier b; b.bar = bar; b.x = xb_xcc_id(); b.st = st;
    if (threadIdx.x == 0) (void)xb_add(&bar[XB_XCNT(b.x)], 1u);
    return b;
}
__device__ __forceinline__ void xcd_barrier_complete(unsigned* bar, unsigned x, unsigned& nloc, unsigned& nx) {
    const unsigned G = gridDim.x * gridDim.y * gridDim.z;
    unsigned sum, cnt, mine, sp = 0u;
    for (;;) {
        sum = 0u; cnt = 0u; mine = 0u;
#pragma unroll
        for (unsigned j = 0; j < 16; ++j) { const unsigned c = xb_ld(&bar[XB_XCNT(j)]); sum += c; cnt += (c > 0u) ? 1u : 0u; mine = (j == x) ? c : mine; }
        if (sum == G) break;
        __builtin_amdgcn_s_sleep(1);
        if ((++sp & 255u) == 0u) { if (xb_ld(&bar[XB_TMO])) break; if (sp > XB_SPIN_CAP) { atomicAdd(&bar[XB_TMO], 1u); break; } }
    }
    nloc = mine > 0u ? mine : 1u; nx = cnt > 0u ? cnt : 1u;
}
__device__ __forceinline__ void xcd_barrier(const XcdBarrier& b, const int wv) {
    asm volatile("s_waitcnt vmcnt(0)" ::: "memory");
    __syncthreads();
    if (wv == 0 && lane_id() == 0) {
        unsigned* bar = b.bar;
        __builtin_amdgcn_s_waitcnt(0);
        unsigned nloc = b.st[0], nx = b.st[1];
        if (nloc == 0u) { xcd_barrier_complete(bar, b.x, nloc, nx); b.st[0] = nloc; b.st[1] = nx; }
        const unsigned old = xb_add(&bar[XB_XSUB(b.x)], 1u);
        const unsigned gen = old / nloc;
        if (old + 1u == (gen + 1u) * nloc) {
            __builtin_amdgcn_fence(__ATOMIC_RELEASE, "agent");
            asm volatile("s_waitcnt vmcnt(0)" ::: "memory");
            const unsigned og = xb_add(&bar[XB_TOP], 1u);
            const unsigned tg = og / nx;
            if (og + 1u == (tg + 1u) * nx) xb_add(&bar[XB_TOPGEN], 1u);
            else XB_SPIN(xb_ld(&bar[XB_TOPGEN]) == tg, bar);
            __builtin_amdgcn_fence(__ATOMIC_ACQUIRE, "agent");
            xb_add(&bar[XB_XGEN(b.x)], 1u);
            asm volatile("s_waitcnt vmcnt(0)" ::: "memory");
        } else {
            XB_SPIN(xb_ld(&bar[XB_XGEN(b.x)]) == gen, bar);
            __builtin_amdgcn_fence(__ATOMIC_ACQUIRE, "agent");
            asm volatile("s_waitcnt vmcnt(0)" ::: "memory");
        }
    }
    __syncthreads();
}

#define LDS_WAIT() asm volatile("s_waitcnt lgkmcnt(0)" ::: "memory")
__device__ __forceinline__ float wave_sum(float v) {
#pragma unroll
    for (int o = 1; o < 64; o <<= 1) v += __shfl_xor(v, o);
    return v;
}
__device__ __forceinline__ int rope_rho(int s) { return 16 * (s >> 5) + 4 * ((s >> 3) & 3) + (s & 3) + 32 * ((s >> 2) & 1); }
__device__ __forceinline__ int src4(int kind, int n) {
    if (kind == 0) return n;
    if (kind == 1) return n < 9216 ? n : (n < 10240 ? n + 24 : (n < 10264 ? n - 1024 : -1));
    if (kind == 2) return n < 2048 ? n : (n < 3072 ? n + 64 : (n < 3136 ? 2048 + rope_rho(n - 3072) : -1));
    if (kind == 3) { if (n < 3072) return (n >> 7) * 192 + (n & 127); const int m = n - 3072; return (m >> 6) * 192 + 128 + rope_rho(m & 63); }
    { if (n < 3072) return (n >> 7) * 256 + (n & 127); const int m = n - 3072; return (m >> 7) * 256 + 128 + (m & 127); }
}
#define CONV_LOAD(V, it_) do { const int kb_ = (it_) / nblk, nb_ = (it_) - kb_ * nblk; const int sc_ = src4(kind, 32 * nb_ + 4 * g); \
        _Pragma("unroll") for (int i = 0; i < 8; ++i) { const int k_ = 64 * kb_ + 8 * i + kr; \
            V[i] = sc_ >= 0 ? ld4(W + (size_t)k_ * Nsrc + sc_) : (f32x4){0.f, 0.f, 0.f, 0.f}; } } while (0)
#define CONV_EMIT(V, it_) do { const int kb_ = (it_) / nblk, nb_ = (it_) - kb_ * nblk, k0_ = 64 * kb_, n0_ = 32 * nb_; \
        _Pragma("unroll") for (int i = 0; i < 8; ++i) { f32x4 v_ = V[i]; if (gf) v_ = v_ * gf[k0_ + 8 * i + kr]; \
            LAS float* s_ = scr + (8 * i + kr) * 33 + 4 * g; s_[0] = v_[0]; s_[1] = v_[1]; s_[2] = v_[2]; s_[3] = v_[3]; } \
        LDS_WAIT(); asm volatile("" ::: "memory"); \
        _Pragma("unroll") for (int j = 0; j < 4; ++j) { const int n_ = (lane >> 3) + 8 * j; const LAS float* s_ = scr + (8 * c) * 33 + n_; \
            u32x4 o_; o_.x = pg8::cvt_pk_bf16(s_[0 * 33], s_[1 * 33]); o_.y = pg8::cvt_pk_bf16(s_[2 * 33], s_[3 * 33]); o_.z = pg8::cvt_pk_bf16(s_[4 * 33], s_[5 * 33]); o_.w = pg8::cvt_pk_bf16(s_[6 * 33], s_[7 * 33]); \
            *(u32x4*)(WT + (blk ? ((size_t)kb_ * Ndst + (n0_ + n_)) * 64 + 8 * c : (size_t)(n0_ + n_) * K + k0_ + 8 * c)) = o_; } \
        LDS_WAIT(); asm volatile("" ::: "memory"); } while (0)
__device__ __forceinline__ void conv_matrix(const float* W, int K, int Nsrc, int Ndst, int kind, const float* gf, bf16* WT, LAS float* scr, int gw, int NGW, int lane, const int blk = 0) {
    const int nblk = Ndst / 32, nitems = (K / 64) * nblk;
    const int g = lane & 7, kr = lane >> 3, c = lane & 7;
    f32x4 va[8], vb[8];
    int it = gw; if (it >= nitems) return;
    CONV_LOAD(va, it);
    for (;;) {
        const int i1 = it + NGW; if (i1 < nitems) CONV_LOAD(vb, i1);
        CONV_EMIT(va, it);
        if (i1 >= nitems) break;
        const int i2 = i1 + NGW; if (i2 < nitems) CONV_LOAD(va, i2);
        CONV_EMIT(vb, i1);
        if (i2 >= nitems) break;
        it = i2;
    }
}
#undef CONV_LOAD
#undef CONV_EMIT
__device__ __forceinline__ void row_to_bf16_rstd(const float* xrow, bf16* obase, int m, int M, float* rstd, int lane) {
    const f32x4* xr = (const f32x4*)xrow + lane; float s = 0.f; f32x4 v[16];
#pragma unroll
    for (int j = 0; j < 16; ++j) { v[j] = xr[64 * j]; s += ss4(v[j]); }
    s = wave_sum(s);
    if (lane == 0) *rstd = rsqrtf(s * (1.f / DM) + EPS);
#pragma unroll
    for (int j = 0; j < 16; ++j) { u32x2 w; w.x = pg8::cvt_pk_bf16(v[j][0], v[j][1]); w.y = pg8::cvt_pk_bf16(v[j][2], v[j][3]); *(u32x2*)(obase + act_off(m, 256 * j + 4 * lane, M, DM)) = w; }
}
__device__ __forceinline__ void build_rtab(LAS float* tab, const float* src, int np, int rbase, int nrows, float inv_dim, const int wv) {
    int t0 = tid_of(wv); asm volatile("" : "+v"(t0));
    for (int r = t0; r < nrows; r += NWAVES * 64) {
        if (np == 0) { tab[r] = src[rbase + r]; continue; }
        const float* p = src + (size_t)(rbase + r) * np; float s = 0.f;
        for (int i = 0; i < np; i += 4) { const f32x4 v = ld4(p + i); s += (v[0] + v[1]) + (v[2] + v[3]); }
        tab[r] = rsqrtf(s * inv_dim + EPS);
    }
}

struct Args {
    const float *x, *mem; const int* pos; const float *mem_norm_g, *w_mem_kv, *mem_k_norm_g, *attn_norm_g, *memq_norm_g, *w_o, *mlp_norm_g, *w_up, *w_down,
        *fox_w_in, *fox_b_f, *fox_q_norm_g, *fox_k_norm_g, *mla_w_in, *mla_q_a_norm_g, *mla_w_q_b, *mla_kv_a_norm_g, *mla_w_kv_b, *mla_q_norm_g, *mla_k_norm_g;
    float* out; unsigned char* ws;
};
struct ArgsG {
    const GAS float *x, *mem; const GAS int* pos; const GAS float *mem_norm_g, *w_mem_kv, *mem_k_norm_g, *attn_norm_g, *memq_norm_g, *w_o, *mlp_norm_g, *w_up, *w_down,
        *fox_w_in, *fox_b_f, *fox_q_norm_g, *fox_k_norm_g, *mla_w_in, *mla_q_a_norm_g, *mla_w_q_b, *mla_kv_a_norm_g, *mla_w_kv_b, *mla_q_norm_g, *mla_k_norm_g;
    GAS float* out; GAS unsigned char* ws;
};
static_assert(sizeof(ArgsG) == sizeof(Args) && sizeof(Args) == 25 * 8, "argument block");
__device__ __forceinline__ Args to_generic(const ArgsG& g) {
    Args a;
    a.x = (const float*)g.x; a.mem = (const float*)g.mem; a.pos = (const int*)g.pos; a.mem_norm_g = (const float*)g.mem_norm_g; a.w_mem_kv = (const float*)g.w_mem_kv;
    a.mem_k_norm_g = (const float*)g.mem_k_norm_g; a.attn_norm_g = (const float*)g.attn_norm_g; a.memq_norm_g = (const float*)g.memq_norm_g; a.w_o = (const float*)g.w_o;
    a.mlp_norm_g = (const float*)g.mlp_norm_g; a.w_up = (const float*)g.w_up; a.w_down = (const float*)g.w_down; a.fox_w_in = (const float*)g.fox_w_in; a.fox_b_f = (const float*)g.fox_b_f;
    a.fox_q_norm_g = (const float*)g.fox_q_norm_g; a.fox_k_norm_g = (const float*)g.fox_k_norm_g; a.mla_w_in = (const float*)g.mla_w_in; a.mla_q_a_norm_g = (const float*)g.mla_q_a_norm_g;
    a.mla_w_q_b = (const float*)g.mla_w_q_b; a.mla_kv_a_norm_g = (const float*)g.mla_kv_a_norm_g; a.mla_w_kv_b = (const float*)g.mla_w_kv_b; a.mla_q_norm_g = (const float*)g.mla_q_norm_g;
    a.mla_k_norm_g = (const float*)g.mla_k_norm_g; a.out = (float*)g.out; a.ws = (unsigned char*)g.ws;
    return a;
}

__global__ void __launch_bounds__(NWAVES * 64, 2) mk_fwd(ArgsG a_in) {
    extern __shared__ __attribute__((aligned(16))) unsigned char lds[];
    LAS unsigned char* L = (LAS unsigned char*)lds;
    const int tid0 = threadIdx.x, wave = __builtin_amdgcn_readfirstlane(tid0 >> 6);
    const int G = gridDim.x, bx = blockIdx.x;
    unsigned char* ws0 = (unsigned char*)a_in.ws;
    volatile LAS unsigned* MISC = (volatile LAS unsigned*)(L + MISC_OFF);
    if (tid0 < 64) MISC[tid0] = 0u;
    __syncthreads();
    XcdBarrier bar = xcd_barrier_post((unsigned*)(ws0 + WS_CTL) + CW_BAR, MISC + 8);
    const int rbase = 2048 * (bx & 7);
    LAS float* TA = (LAS float*)(L + L_TA); LAS float* TB = (LAS float*)(L + L_TB);
#if defined(__HIP_DEVICE_COMPILE__)
#define LOAD_ARGS(a, ap) const ArgsG ag_ = *(ap); const Args a = to_generic(ag_)
#else
#define LOAD_ARGS(a, ap) const Args a = to_generic(a_in)
#endif
#define PHASE_VARS const __attribute__((address_space(4))) ArgsG* ap_ = (const __attribute__((address_space(4))) ArgsG*)__builtin_amdgcn_kernarg_segment_ptr(); asm volatile("" : "+s"(ap_)); LOAD_ARGS(a, ap_); \
    GAS unsigned char* wsg_ = (GAS unsigned char*)a.ws; asm volatile("" : "+s"(wsg_)); unsigned char* ws = (unsigned char*)wsg_; int tid = tid_of(wave); asm volatile("" : "+v"(tid)); (void)tid; const int lane = tid & 63; (void)lane; \
    bf16* XB = (bf16*)(ws + WS_XB); float* RSSA = (float*)(ws + WS_RSSA); float* RSSB = (float*)(ws + WS_RSSB); float* COS = (float*)(ws + WS_COS); float* SIN = (float*)(ws + WS_SIN); \
    float* MQSS = (float*)(ws + WS_MQSS); float* QSS = (float*)(ws + WS_QSS); float* KSS = (float*)(ws + WS_KSS); \
    float* MQSS1 = (float*)(ws + WS_MQSS1); float* QSS1 = (float*)(ws + WS_QSS1); float* KSS1 = (float*)(ws + WS_KSS1); (void)MQSS1; (void)QSS1; (void)KSS1; \
    (void)XB; (void)RSSA; (void)RSSB; (void)COS; (void)SIN; (void)MQSS; (void)QSS; (void)KSS;

    if constexpr ((PHASES >> 0) & 1)
    for (int rep_ = 0; rep_ < REP_P0; ++rep_)
    { PHASE_VARS
        const int vcu = (G % 8 == 0) ? (bx % 8) * (G / 8) + bx / 8 : bx;
        const int gw = vcu * NWAVES + wave, NGW = G * NWAVES;
        LAS float* scr = (LAS float*)(L + wave * 16384);
        conv_matrix(a.fox_w_in, DM, FOX_SRC, FOXN, 1, a.attn_norm_g, (bf16*)(ws + WS_W_FOXIN), scr, gw, NGW, lane, W_BLK);
        if (G != 256) conv_matrix(a.w_o + (size_t)DM * DM, DM, DM, DM, 0, nullptr, (bf16*)(ws + WS_W_O1), scr, gw, NGW, lane, W_BLK);
        conv_matrix(a.w_mem_kv, DM, 2048, 2048, 0, a.mem_norm_g, (bf16*)(ws + WS_W_MEMKV), scr, gw, NGW, lane, W_BLK);
        for (int m = gw; m < T; m += NGW) row_to_bf16_rstd(a.x + (size_t)m * DM, XB, m, T, (float*)(ws + WS_RSTD0) + m, lane);
        for (int m = gw; m < MT; m += NGW) row_to_bf16_rstd(a.mem + (size_t)m * DM, (bf16*)(ws + WS_MEMN), m, MT, (float*)(ws + WS_RSTDM) + m, lane);
        for (int idx = (vcu * NWAVES * 64) + tid; idx < T * 32; idx += G * NWAVES * 64) {
            const int tok = idx >> 5, i = idx & 31;
            const float invf = 1.0f / powf(10000.0f, (float)(2 * i) * (1.0f / 64.0f));
            const float ang = (float)a.pos[tok] * invf; float sn, cs; sincosf(ang, &sn, &cs);
            COS[idx] = cs; SIN[idx] = sn;
        }
    }
    xcd_barrier(bar, wave);

    if constexpr ((PHASES >> 1) & 1)
    for (int rep_ = 0; rep_ < REP_IN; ++rep_)
    { PHASE_VARS if (rep_) __syncthreads();
        build_rtab(TA, (const float*)(ws + WS_RSTD0), 0, rbase, 2048, 0.f, wave);
        build_rtab(TB, (const float*)(ws + WS_RSTDM), 0, 0, MT, 0.f, wave);
        __syncthreads();
        { pg8::Gemm g{(const bf16*)(ws + WS_MEMN), (const bf16*)(ws + WS_W_MEMKV), MT, 2048, DM, W_BLK, A_BLK}; pg8::StaticOrder S; S.init(MT, 2048, G, (bx >= 64 && bx < 96) ? bx - 64 : (1 << 20));
          EpiMemKV E{(bf16*)(ws + WS_MK), (bf16*)(ws + WS_MV), (float*)(ws + WS_MKSS), TB, 0};
          pg8::gemm_phase<EpiMemKV, pg8::StaticOrder, true, true>(L, g, S, E, wave); }
        { pg8::Gemm g{XB, (const bf16*)(ws + WS_W_FOXIN), T, FOXN, DM, W_BLK, A_BLK}; pg8::StaticOrder S; S.init(T, FOXN, G, bx);
          EpiFoxIn E{(bf16*)(ws + WS_FQ), (bf16*)(ws + WS_QM), (WS_FK - WS_FQ) / 2, QSS, KSS, MQSS, (float*)(ws + WS_LOGF),
                     a.fox_q_norm_g, a.fox_k_norm_g, a.memq_norm_g, a.mem_k_norm_g, a.fox_b_f, TA, rbase};
          pg8::gemm_phase<EpiFoxIn, pg8::StaticOrder, true, true>(L, g, S, E, wave); }
        if (G == 256 && bx >= 96) conv_matrix(a.w_up + (size_t)DM * FF, DM, FF, FF, 0, a.mlp_norm_g + DM, (bf16*)(ws + WS_W_UP1), (LAS float*)(L + wave * 16384), (bx - 96) * NWAVES + wave, 160 * NWAVES, lane, W_BLK);
        else if (G != 256) conv_matrix(a.w_up + (size_t)DM * FF, DM, FF, FF, 0, a.mlp_norm_g + DM, (bf16*)(ws + WS_W_UP1), (LAS float*)(L + wave * 16384), bx * NWAVES + wave, G * NWAVES, lane, W_BLK);
    }
    xcd_barrier(bar, wave);

    if constexpr ((PHASES >> 2) & 1)
    for (int rep_ = 0; rep_ < REP_ATT; ++rep_)
    { PHASE_VARS if (rep_) __syncthreads();
        char* al = (char*)lds;
#define P2_CONV() do { const int vcu = (G % 8 == 0) ? (bx % 8) * (G / 8) + bx / 8 : bx; const int gw = vcu * NWAVES + wave, NGW = G * NWAVES; LAS float* scr = (LAS float*)(L + wave * 16384); \
            int lane_c = lane_id(); asm volatile("" : "+v"(lane_c));     \
            __syncthreads(); \
            conv_matrix(a.w_o, DM, DM, DM, 0, nullptr, (bf16*)(ws + WS_W_O0), scr, gw, NGW, lane_c, W_BLK); \
            conv_matrix(a.w_up, DM, FF, FF, 0, a.mlp_norm_g, (bf16*)(ws + WS_W_UP0), scr, gw, NGW, lane_c, W_BLK); \
            conv_matrix(a.w_down, FF, DM, DM, 0, nullptr, (bf16*)(ws + WS_W_DN0), scr, gw, NGW, lane_c, W_BLK); \
            conv_matrix(a.mla_w_in, DM, MLA_SRC, MLAN, 2, a.attn_norm_g + DM, (bf16*)(ws + WS_W_MLAIN), scr, gw, NGW, lane_c, W_BLK); \
            conv_matrix(a.mla_w_q_b, QLR, QBN, QBN, 3, a.mla_q_a_norm_g, (bf16*)(ws + WS_W_QB), scr, gw, NGW, lane_c, W_BLK); \
            conv_matrix(a.mla_w_kv_b, KVLR, KVBN, KVBN, 4, a.mla_kv_a_norm_g, (bf16*)(ws + WS_W_KVB), scr, gw, NGW, lane_c, W_BLK); \
            __syncthreads(); } while (0)
        float skip_th;
        { float gm = 0.f; for (int d = 0; d < 128; d += 4) { const f32x4 g4 = ld4(a.fox_q_norm_g + d) * ld4(a.fox_k_norm_g + d); gm = fmaxf(fmaxf(gm, fmaxf(fabsf(g4[0]), fabsf(g4[1]))), fmaxf(fabsf(g4[2]), fabsf(g4[3]))); }
          skip_th = 34.f * gm + 136.f + 8.f; }
        asm volatile("" : "+v"(skip_th) :: "memory");
        bool conv_done = (rep_ != 0); const int conv_pos = (bx >> 3) & 3;
        if constexpr (ATT_SELF) for (int i = 0;; ++i) {
            if (!conv_done && i == conv_pos) { P2_CONV(); conv_done = true; }
            int Lid = i * G + bx; if (Lid >= 768 * ATT_WRAP) break; Lid = Lid >= 768 ? Lid - 768 : Lid;
            const int xcd = Lid & 7, k = Lid >> 3, bh = xcd * 12 + (k >> 3), x = ((k & 7) + 3 * (k >> 5)) & 7, b = bh / NH, h = bh - b * NH;
            const int nkeys = 256 * (16 - x);
            att::build_decay(al, (const float*)(ws + WS_LOGF) + (size_t)bh * SEQ, nkeys, wave);
            { int tl = tid_of(wave); asm volatile("" : "+v"(tl)); float* RKt = (float*)(al + att::l_rk(128)); const float* kp = KSS + ((size_t)b * SEQ * NH + h) * 4;
              for (int s = tl; s < nkeys; s += NWAVES * 64) { const f32x4 p = ld4(kp + (size_t)s * NH * 4); RKt[s] = rsqrtf(((p[0] + p[1]) + (p[2] + p[3])) * (1.f / 128.f) + EPS) * (0.08838834764831845f * LOG2E); } }
            __syncthreads();
            for (int pass = 0; pass < 2; ++pass) {
                const int qb = pass ? 15 - x : x; const size_t r0 = (size_t)b * SEQ + qb * 256;
                att::Blk B;
                B.Qa = (const bf16*)(ws + WS_FQ) + ((size_t)h * T + r0) * 128; B.Qb = B.Qa;
                B.Ka = (const bf16*)(ws + WS_FK) + ((size_t)h * T + (size_t)b * SEQ) * 128; B.Kb = B.Ka;
                B.V = (const bf16*)(ws + WS_FV) + ((size_t)h * T + (size_t)b * SEQ) * 128;
                B.O = (bf16*)(ws + WS_MIX); B.orow0 = (int)r0; B.ocol0 = h * 128;
                B.qssp = QSS + (r0 * NH + h) * 4;
                B.nkt = 4 * (qb + 1); B.qpos0 = qb * 256;
                { const float* NDLt = (const float*)(al + att::l_dl(128)); const int kt_ = lane_id(); const float ref_ = NDLt[qb * 256];
                  const bool need_ = kt_ < B.nkt && !(ref_ - NDLt[64 * kt_ + 63] > skip_th);
                  const unsigned long long mk_ = __ballot(need_); const int ktmin_ = mk_ ? (int)__builtin_ctzll(mk_) : 0;
                  B.nrun = B.nkt - __builtin_amdgcn_readfirstlane(ktmin_); }
                att::attn_block<128, 128, 4, true, true, true, true, att::Pitch<128, 128, 128, 128, 128, NH * 4>>(al, B, wave);
            }
        }
        if (!conv_done) P2_CONV();
#undef P2_CONV
        if constexpr (ATT_MEM) for (int u_ = bx; u_ < NB * NMH * 16 * ATT_WRAP; u_ += G) { const int u = u_ & 255;
            const int b = u >> 6, mh = (u >> 4) & 3, qb = u & 15; const size_t r0 = (size_t)b * SEQ + qb * 256;
            __syncthreads();
            { int tl = tid_of(wave); asm volatile("" : "+v"(tl)); float* RKt = (float*)(al + att::l_rk(256)); const float* kp = (const float*)(ws + WS_MKSS) + ((size_t)mh * MT + (size_t)b * MLEN) * 4;
              for (int s = tl; s < MLEN; s += NWAVES * 64) { const f32x4 p = ld4(kp + (size_t)s * 4); RKt[s] = rsqrtf(((p[0] + p[1]) + (p[2] + p[3])) * (1.f / 256.f) + EPS) * (0.0625f * LOG2E); } }
            __syncthreads();
            for (int pass = 0; pass < 2; ++pass) {
                att::Blk B;
                B.Qa = (const bf16*)(ws + WS_QM) + ((size_t)mh * T + r0) * 256; B.Qb = B.Qa;
                B.Ka = (const bf16*)(ws + WS_MK) + (size_t)b * MLEN * 1024 + mh * 256; B.Kb = B.Ka;
                B.V = (const bf16*)(ws + WS_MV) + (size_t)b * MLEN * 1024 + mh * 256 + pass * 128;
                B.O = (bf16*)(ws + WS_MIX); B.orow0 = (int)r0; B.ocol0 = 3072 + mh * 256 + pass * 128;
                B.qssp = MQSS + (r0 * NMH + mh) * 4;
                B.nkt = 4; B.nrun = 4; B.qpos0 = 0;
                att::attn_block<256, 256, 4, false, false, false, false, att::Pitch<256, 256, 1024, 1024, 1024, NMH * 4>>(al, B, wave);
            }
        }
    }
    xcd_barrier(bar, wave);

    if constexpr ((PHASES >> 3) & 1)
    for (int rep_ = 0; rep_ < REP_WO; ++rep_)
    { constexpr int REP_X = REP_WO; PHASE_VARS if (rep_) __syncthreads(); pg8::Gemm g{(const bf16*)(ws + WS_MIX), (const bf16*)(ws + WS_W_O0), T, DM, DM, W_BLK, A_BLK}; pg8::StaticOrder S; S.init(T, DM, G, bx);
      EpiRes<false> E{XB, (rep_ + 1 < REP_X) ? (bf16*)(ws + WS_END) : XB, nullptr, RSSA};
      pg8::gemm_phase<EpiRes<false>, pg8::StaticOrder, true, true>(L, g, S, E, wave); }
    xcd_barrier(bar, wave);

    if constexpr ((PHASES >> 4) & 1)
    for (int rep_ = 0; rep_ < REP_UP; ++rep_)
    { PHASE_VARS if (rep_) __syncthreads(); build_rtab(TA, RSSA, 64, rbase, 2048, 1.f / DM, wave); __syncthreads();
      pg8::Gemm g{XB, (const bf16*)(ws + WS_W_UP0), T, FF, DM, W_BLK, A_BLK}; pg8::StaticOrder S; S.init(T, FF, G, bx);
      EpiUp E{(bf16*)(ws + WS_HID), TA, rbase};
      pg8::gemm_phase<EpiUp, pg8::StaticOrder, true, true>(L, g, S, E, wave); }
    xcd_barrier(bar, wave);

    if constexpr ((PHASES >> 5) & 1)
    for (int rep_ = 0; rep_ < REP_DN; ++rep_)
    { constexpr int REP_X = REP_DN; PHASE_VARS if (rep_) __syncthreads(); pg8::Gemm g{(const bf16*)(ws + WS_HID), (const bf16*)(ws + WS_W_DN0), T, DM, FF, W_BLK, HID_BLK}; pg8::StaticOrder S; S.init(T, DM, G, bx);
      EpiRes<false> E{XB, (rep_ + 1 < REP_X) ? (bf16*)(ws + WS_END) : XB, nullptr, RSSB};
      pg8::gemm_phase<EpiRes<false>, pg8::StaticOrder, true, true>(L, g, S, E, wave); }
    xcd_barrier(bar, wave);

    if constexpr ((PHASES >> 6) & 1)
    for (int rep_ = 0; rep_ < REP_IN; ++rep_)
    { PHASE_VARS if (rep_) __syncthreads(); build_rtab(TA, RSSB, 64, rbase, 2048, 1.f / DM, wave); __syncthreads();
      pg8::Gemm g{XB, (const bf16*)(ws + WS_W_MLAIN), T, MLAN, DM, W_BLK, A_BLK}; pg8::StaticOrder S; S.init(T, MLAN, G, bx);
      EpiMlaIn E{(bf16*)(ws + WS_CQ), (bf16*)(ws + WS_CKV), (bf16*)(ws + WS_QM1), (bf16*)(ws + WS_RK), (float*)(ws + WS_CQSS), (float*)(ws + WS_CKVSS), MQSS1, (float*)(ws + WS_KRSS),
                 a.memq_norm_g + 256, a.mem_k_norm_g, a.mla_k_norm_g, COS, SIN, TA, rbase};
      pg8::gemm_phase<EpiMlaIn, pg8::StaticOrder, true, true>(L, g, S, E, wave);
      if (G == 256 && bx >= 64) conv_matrix(a.w_down + (size_t)FF * DM, FF, DM, DM, 0, nullptr, (bf16*)(ws + WS_W_DN1), (LAS float*)(L + wave * 16384), (bx - 64) * NWAVES + wave, 192 * NWAVES, lane, W_BLK);
      else if (G != 256) conv_matrix(a.w_down + (size_t)FF * DM, FF, DM, DM, 0, nullptr, (bf16*)(ws + WS_W_DN1), (LAS float*)(L + wave * 16384), bx * NWAVES + wave, G * NWAVES, lane, W_BLK); }
    xcd_barrier(bar, wave);

    if constexpr ((PHASES >> 7) & 1)
    for (int rep_ = 0; rep_ < REP_IN; ++rep_)
    { PHASE_VARS if (rep_) __syncthreads(); build_rtab(TA, (const float*)(ws + WS_CQSS), 24, rbase, 2048, 1.f / QLR, wave); build_rtab(TB, (const float*)(ws + WS_CKVSS), 8, rbase, 2048, 1.f / KVLR, wave); __syncthreads();
      { pg8::Gemm g{(const bf16*)(ws + WS_CQ), (const bf16*)(ws + WS_W_QB), T, QBN, QLR, W_BLK, A_BLK}; pg8::StaticOrder S; S.init(T, QBN, G, bx);
        EpiQB E{(bf16*)(ws + WS_QN), (bf16*)(ws + WS_QR), QSS1, a.mla_q_norm_g, a.mla_k_norm_g, COS, SIN, TA, rbase};
        pg8::gemm_phase<EpiQB, pg8::StaticOrder, true, true>(L, g, S, E, wave); }
      { pg8::Gemm g{(const bf16*)(ws + WS_CKV), (const bf16*)(ws + WS_W_KVB), T, KVBN, KVLR, W_BLK, A_BLK}; pg8::StaticOrder S; S.init(T, KVBN, G, (bx + 128) % G);
        EpiKVB E{(bf16*)(ws + WS_KN), (bf16*)(ws + WS_VV), KSS1, TB, rbase};
        pg8::gemm_phase<EpiKVB, pg8::StaticOrder, true, true>(L, g, S, E, wave); }
      if (G == 256 && bx >= 128) conv_matrix(a.w_o + (size_t)DM * DM, DM, DM, DM, 0, nullptr, (bf16*)(ws + WS_W_O1), (LAS float*)(L + wave * 16384), (bx - 128) * NWAVES + wave, 128 * NWAVES, lane, W_BLK);
}
    xcd_barrier(bar, wave);

    if constexpr ((PHASES >> 8) & 1)
    for (int rep_ = 0; rep_ < REP_ATT; ++rep_)
    { PHASE_VARS if (rep_) __syncthreads();
        char* al = (char*)lds;
        if constexpr (ATT_SELF) for (int i = 0;; ++i) {
            int Lid = i * G + bx; if (Lid >= 768 * ATT_WRAP) break; Lid = Lid >= 768 ? Lid - 768 : Lid;
            const int xcd = Lid & 7, k = Lid >> 3, bh = xcd * 12 + (k >> 3), x = k & 7, b = bh / NH, h = bh - b * NH;
            const int nkeys = 256 * (16 - x);
            __syncthreads();
            { int tl = tid_of(wave); asm volatile("" : "+v"(tl)); float* RKt = (float*)(al + att::l_rk(192)); const float* kp = KSS1 + ((size_t)b * SEQ * NH + h) * 4; const float* rp = (const float*)(ws + WS_KRSS) + (size_t)b * SEQ * 2;
              for (int s = tl; s < nkeys; s += NWAVES * 64) { const f32x4 p = ld4(kp + (size_t)s * NH * 4); const f32x2 q = *(const f32x2*)(rp + (size_t)s * 2);
                  RKt[s] = rsqrtf((((p[0] + p[1]) + (p[2] + p[3])) + (q[0] + q[1])) * (1.f / 192.f) + EPS) * (0.07216878364870323f * LOG2E); } }
            __syncthreads();
            for (int pass = 0; pass < 2; ++pass) {
                const int qb = pass ? 15 - x : x; const size_t r0 = (size_t)b * SEQ + qb * 256;
                att::Blk B;
                B.Qa = (const bf16*)(ws + WS_QN) + ((size_t)h * T + r0) * 128; B.Qb = (const bf16*)(ws + WS_QR) + ((size_t)h * T + r0) * 64;
                B.Ka = (const bf16*)(ws + WS_KN) + ((size_t)h * T + (size_t)b * SEQ) * 128; B.Kb = (const bf16*)(ws + WS_RK) + (size_t)b * SEQ * 64;
                B.V = (const bf16*)(ws + WS_VV) + ((size_t)h * T + (size_t)b * SEQ) * 128;
                B.O = (bf16*)(ws + WS_MIX1); B.orow0 = (int)r0; B.ocol0 = h * 128;
                B.qssp = QSS1 + (r0 * NH + h) * 8;
                B.nkt = 4 * (qb + 1); B.nrun = B.nkt; B.qpos0 = qb * 256;
                att::attn_block<192, 128, 6, true, false, true, false, att::Pitch<128, 64, 128, 64, 128, NH * 8>>(al, B, wave);
            }
        }
        if constexpr (ATT_MEM) for (int u_ = bx; u_ < NB * NMH * 16 * ATT_WRAP; u_ += G) { const int u = u_ & 255;
            const int b = u >> 6, mh = (u >> 4) & 3, qb = u & 15; const size_t r0 = (size_t)b * SEQ + qb * 256;
            __syncthreads();
            { int tl = tid_of(wave); asm volatile("" : "+v"(tl)); float* RKt = (float*)(al + att::l_rk(256)); const float* kp = (const float*)(ws + WS_MKSS) + ((size_t)mh * MT + (size_t)b * MLEN) * 4;
              for (int s = tl; s < MLEN; s += NWAVES * 64) { const f32x4 p = ld4(kp + (size_t)s * 4); RKt[s] = rsqrtf(((p[0] + p[1]) + (p[2] + p[3])) * (1.f / 256.f) + EPS) * (0.0625f * LOG2E); } }
            __syncthreads();
            for (int pass = 0; pass < 2; ++pass) {
                att::Blk B;
                B.Qa = (const bf16*)(ws + WS_QM1) + ((size_t)mh * T + r0) * 256; B.Qb = B.Qa;
                B.Ka = (const bf16*)(ws + WS_MK) + (size_t)b * MLEN * 1024 + mh * 256; B.Kb = B.Ka;
                B.V = (const bf16*)(ws + WS_MV) + (size_t)b * MLEN * 1024 + mh * 256 + pass * 128;
                B.O = (bf16*)(ws + WS_MIX1); B.orow0 = (int)r0; B.ocol0 = 3072 + mh * 256 + pass * 128;
                B.qssp = MQSS1 + (r0 * NMH + mh) * 4;
                B.nkt = 4; B.nrun = 4; B.qpos0 = 0;
                att::attn_block<256, 256, 4, false, false, false, false, att::Pitch<256, 256, 1024, 1024, 1024, NMH * 4>>(al, B, wave);
            }
        }
    }
    xcd_barrier(bar, wave);

    if constexpr ((PHASES >> 9) & 1)
    for (int rep_ = 0; rep_ < REP_WO; ++rep_)
    { constexpr int REP_X = REP_WO; PHASE_VARS if (rep_) __syncthreads(); pg8::Gemm g{(const bf16*)(ws + WS_MIX1), (const bf16*)(ws + WS_W_O1), T, DM, DM, W_BLK, A_BLK}; pg8::StaticOrder S; S.init(T, DM, G, bx);
      EpiRes<false> E{XB, (rep_ + 1 < REP_X) ? (bf16*)(ws + WS_END) : XB, nullptr, RSSA};
      pg8::gemm_phase<EpiRes<false>, pg8::StaticOrder, true, true>(L, g, S, E, wave); }
    xcd_barrier(bar, wave);

    if constexpr ((PHASES >> 10) & 1)
    for (int rep_ = 0; rep_ < REP_UP; ++rep_)
    { PHASE_VARS if (rep_) __syncthreads(); build_rtab(TA, RSSA, 64, rbase, 2048, 1.f / DM, wave); __syncthreads();
      pg8::Gemm g{XB, (const bf16*)(ws + WS_W_UP1), T, FF, DM, W_BLK, A_BLK}; pg8::StaticOrder S; S.init(T, FF, G, bx);
      EpiUp E{(bf16*)(ws + WS_HID), TA, rbase};
      pg8::gemm_phase<EpiUp, pg8::StaticOrder, true, true>(L, g, S, E, wave); }
    xcd_barrier(bar, wave);

    if constexpr ((PHASES >> 11) & 1)
    { PHASE_VARS pg8::Gemm g{(const bf16*)(ws + WS_HID), (const bf16*)(ws + WS_W_DN1), T, DM, FF, W_BLK, HID_BLK}; pg8::StaticOrder S; S.init(T, DM, G, bx);
      EpiRes<true> E{XB, XB, a.out, nullptr};
      pg8::gemm_phase<EpiRes<true>, pg8::StaticOrder, true, true>(L, g, S, E, wave); }
}

extern "C" void kernel_launch(void* const* d_in, const int* in_sizes, int n_in, void* d_out, int out_size, void* d_ws, size_t ws_size, hipStream_t stream) {
    static int grid = 0;
    if (grid == 0) {
        if (n_in != 23 || ws_size < WS_END) { fprintf(stderr, "kernel_launch: need 23 inputs and >= %zu bytes of workspace; got %d, %zu\n", (size_t)WS_END, n_in, ws_size); grid = -1; return; }
        int dev = 0, cus = 0, per_cu = 0;
        if (hipGetDevice(&dev) != hipSuccess || hipDeviceGetAttribute(&cus, hipDeviceAttributeMultiprocessorCount, dev) != hipSuccess) { grid = -1; return; }
        if (hipFuncSetAttribute((const void*)mk_fwd, hipFuncAttributeMaxDynamicSharedMemorySize, LDS_BYTES) != hipSuccess) { fprintf(stderr, "kernel_launch: hipFuncSetAttribute failed\n"); grid = -1; return; }
        if (hipOccupancyMaxActiveBlocksPerMultiprocessor(&per_cu, (const void*)mk_fwd, NWAVES * 64, LDS_BYTES) != hipSuccess || per_cu < 1) { fprintf(stderr, "kernel_launch: occupancy query says %d\n", per_cu); }
        (void)hipGetLastError();
        grid = cus;
        if (grid % 8 != 0) grid -= grid % 8;
    }
    if (grid <= 0) return;
    (void)hipMemsetAsync((char*)d_ws + WS_CTL, 0, CTL_ZERO_BYTES, stream);
    Args a{};
    a.x = (const float*)d_in[0]; a.mem = (const float*)d_in[1]; a.pos = (const int*)d_in[2]; a.mem_norm_g = (const float*)d_in[3]; a.w_mem_kv = (const float*)d_in[4];
    a.mem_k_norm_g = (const float*)d_in[5]; a.attn_norm_g = (const float*)d_in[6]; a.memq_norm_g = (const float*)d_in[7]; a.w_o = (const float*)d_in[8];
    a.mlp_norm_g = (const float*)d_in[9]; a.w_up = (const float*)d_in[10]; a.w_down = (const float*)d_in[11]; a.fox_w_in = (const float*)d_in[12]; a.fox_b_f = (const float*)d_in[13];
    a.fox_q_norm_g = (const float*)d_in[14]; a.fox_k_norm_g = (const float*)d_in[15]; a.mla_w_in = (const float*)d_in[16]; a.mla_q_a_norm_g = (const float*)d_in[17];
    a.mla_w_q_b = (const float*)d_in[18]; a.mla_kv_a_norm_g = (const float*)d_in[19]; a.mla_w_kv_b = (const float*)d_in[20]; a.mla_q_norm_g = (const float*)d_in[21];
    a.mla_k_norm_g = (const float*)d_in[22];
    a.out = (float*)d_out; a.ws = (unsigned char*)d_ws;
    ArgsG ag{}; static_assert(sizeof(ag) == sizeof(a), ""); memcpy(&ag, &a, sizeof(a));
    hipLaunchKernelGGL(mk_fwd, dim3(grid), dim3(NWAVES * 64), LDS_BYTES, stream, ag);
}
```

```cpp
#include <hip/hip_runtime.h>
#include <cstdio>
#include <cstdint>
#include <cstring>

#define LAS __attribute__((address_space(3)))
#define GAS __attribute__((address_space(1)))
typedef unsigned short bf16;
typedef short bf16x8 __attribute__((ext_vector_type(8)));
typedef short s16x4 __attribute__((ext_vector_type(4)));
typedef float f32x2 __attribute__((ext_vector_type(2)));
typedef float f32x4 __attribute__((ext_vector_type(4)));
typedef float f32x8 __attribute__((ext_vector_type(8)));
typedef float f32x16 __attribute__((ext_vector_type(16)));
typedef unsigned u32x4 __attribute__((ext_vector_type(4)));
typedef unsigned u32x2 __attribute__((ext_vector_type(2)));

#ifndef HID_BLK
#define HID_BLK 1
#endif
#ifndef A_BLK
#define A_BLK 1
#endif
constexpr int NB = 4, SEQ = 4096, T = NB * SEQ, DM = 4096, NH = 24, FF = 16384, MLEN = 256, MT = NB * MLEN, NMH = 4;
constexpr int FOX_SRC = 10264, FOXN = 10496;
constexpr int MLA_SRC = 3136, MLAN = 3328;
constexpr int QLR = 1536, KVLR = 512, QBN = 4608, KVBN = 6144;
constexpr float EPS = 1e-6f, LOG2E = 1.4426950408889634f;
__device__ __forceinline__ size_t act_off(int row, int col, int M, int ld) { return A_BLK ? ((size_t)(col >> 6) * M + row) * 64 + (col & 63) : (size_t)row * ld + col; }

__device__ __forceinline__ int lane_id() { int l; asm volatile("v_mbcnt_lo_u32_b32 %0, -1, 0\n\tv_mbcnt_hi_u32_b32 %0, -1, %0" : "=v"(l)); return l; }
__device__ __forceinline__ int tid_of(int wv) { return (wv << 6) | lane_id(); }

namespace pg8 {
constexpr int BM = 256, BK = 64, HALF = 128, HTB = HALF * BK * 2, STAGE_BYTES = 8 * HTB, NXCD = 8, WGM = 8;
__host__ __device__ __forceinline__ int lds_byte(int r, int c) { const int st = (r >> 4) * 2 + (c >> 5), rr = r & 15, cc = c & 31, ob = rr * 64 + cc * 2; return st * 1024 + (ob ^ (((ob >> 9) & 1) << 5)); }
__host__ __device__ __forceinline__ void stage_rc(int b, int& R, int& C) { const int st = b / 1024, sb = b % 1024, swz = sb ^ (((sb >> 9) & 1) << 5); R = (st >> 1) * 16 + swz / 64; C = (st & 1) * 32 + (swz % 64) / 2; }
__host__ __device__ __forceinline__ int perm32(int rho) { const int n = rho >> 4, i = rho & 15; return 8 * (i >> 2) + 4 * n + (i & 3); }
struct Unit { int pm, pn; };
struct Gemm { const bf16* A; const bf16* Bt; int M, N, K; int bblk; int ablk; };
struct StaticOrder {
    int nM, nN, nwg, G, c;
    __device__ void init(int M, int N, int G_, int c_) { nM = M / BM; nN = N / BM; nwg = nM * nN; G = G_; c = c_; }
    __device__ bool next(int i, Unit& u) const {
        const long L = (long)i * G + c; if (L >= nwg) return false;
        int wgid = (int)L; { const int q = nwg / NXCD, r = nwg % NXCD, xcd = wgid % NXCD, off = wgid / NXCD; wgid = (xcd < r ? xcd * (q + 1) : r * (q + 1) + (xcd - r) * q) + off; }
        const int nig = WGM * nN, gid = wgid / nig, fm = gid * WGM, gsz = (nM - fm) < WGM ? (nM - fm) : WGM;
        u.pm = fm + ((wgid % nig) % gsz); u.pn = (wgid % nig) / gsz; return true;
    }
    __device__ __forceinline__ void a_ready(const Unit&) const {}
    __device__ __forceinline__ void done(const Unit&) const {}
};
typedef __bf16 bf16x2_t __attribute__((ext_vector_type(2)));
__device__ __forceinline__ unsigned cvt_pk_bf16(float lo, float hi) { const f32x2 v = {lo, hi}; const bf16x2_t b = __builtin_convertvector(v, bf16x2_t); return __builtin_bit_cast(unsigned, b); }

template <class Epi, class Sched, bool ALIGN_EPI = false, bool SP2 = false>
__device__ __forceinline__ void gemm_phase(LAS unsigned char* lds, const Gemm g, const Sched& S, const Epi& E, const int wv) {
    int tid = tid_of(wv); asm volatile("" : "+v"(tid));
    const int wid = __builtin_amdgcn_readfirstlane(tid >> 6), lane = tid & 63, wr = wid >> 2, wc = wid & 3, fr = lane & 15, fq = lane >> 4;
    const int K = g.K, nt = K / BK;
    unsigned voffA[2], voffB[2];
#pragma unroll
    for (int i = 0; i < 2; ++i) { int R, C; stage_rc(tid * 16 + i * 8192, R, C); const int Rb = Epi::PERM ? ((R & ~31) + perm32(R & 31)) : R;
        voffA[i] = (unsigned)(R * (g.ablk ? BK : K) + C) * 2u; voffB[i] = (unsigned)(Rb * (g.bblk ? BK : K) + C) * 2u; }
    const size_t kstep = (size_t)(BK * 2);
    const size_t hstep = (size_t)HALF * K * 2;
    const size_t tstep = 2 * hstep;
    const size_t kstepA = g.ablk ? (size_t)g.M * BK * 2 : kstep, hstepA = g.ablk ? (size_t)HALF * BK * 2 : hstep, tstepA = 2 * hstepA;
    const size_t kstepB = g.bblk ? (size_t)g.N * BK * 2 : kstep, hstepB = g.bblk ? (size_t)HALF * BK * 2 : hstep, tstepB = 2 * hstepB;
    const unsigned ldsw = (unsigned)wid * 1024u;
    const int aoff = lds_byte(wr * 64 + fr, fq * 8), boff = lds_byte(wc * 32 + fr, fq * 8);
#define PG8_SA(b, h) (((b) * 2 + (h)) * HTB)
#define PG8_SB(b, h) ((4 + (b) * 2 + (h)) * HTB)
#define PG8_STAGE(bufoff, gbase, voff) do { _Pragma("unroll") for (int _i = 0; _i < 2; ++_i) \
        __builtin_amdgcn_global_load_lds((const unsigned*)((const char*)(gbase) + (voff)[_i]), (LAS unsigned*)(lds + (bufoff) + ldsw + _i * 8192), 16, 0, 0); } while (0)
#define PG8_LDA(dst, b, h) do { _Pragma("unroll") for (int m = 0; m < 4; ++m) _Pragma("unroll") for (int k = 0; k < 2; ++k) dst[m][k] = *(const LAS bf16x8*)(lds + PG8_SA(b, h) + aoff + m * 2048 + k * 1024); } while (0)
#define PG8_LDB(dst, b, h) do { _Pragma("unroll") for (int n = 0; n < 2; ++n) _Pragma("unroll") for (int k = 0; k < 2; ++k) dst[n][k] = *(const LAS bf16x8*)(lds + PG8_SB(b, h) + boff + n * 2048 + k * 1024); } while (0)
#define PG8_MMA(ai, bj, At, Bt) do { __builtin_amdgcn_s_setprio(1); _Pragma("unroll") for (int m = 0; m < 4; ++m) _Pragma("unroll") for (int n = 0; n < 2; ++n) _Pragma("unroll") for (int k = 0; k < 2; ++k) \
        acc[ai][bj][m][n] = __builtin_amdgcn_mfma_f32_16x16x32_bf16(Bt[n][k], At[m][k], acc[ai][bj][m][n], 0, 0, 0); __builtin_amdgcn_s_setprio(0); } while (0)
#define PG8_WAIT_V(n) asm volatile("s_waitcnt vmcnt(" #n ")" ::: "memory")
#define PG8_WAIT_L(n) asm volatile("s_waitcnt lgkmcnt(" #n ")" ::: "memory")
#define PG8_BAR __builtin_amdgcn_s_barrier()
#define PG8_SCHED __builtin_amdgcn_sched_barrier(0)
    Unit cur, nxt; int ui = 0;
    if (!S.next(0, cur)) return;
    f32x4 acc[2][2][4][2];
#pragma unroll
    for (int a = 0; a < 2; ++a)
#pragma unroll
        for (int b = 0; b < 2; ++b)
#pragma unroll
            for (int m = 0; m < 4; ++m)
#pragma unroll
                for (int n = 0; n < 2; ++n) acc[a][b][m][n] = (f32x4){0.f, 0.f, 0.f, 0.f};
    bf16x8 At[4][2], B0[2][2], B1[2][2];
    const char* cA = (const char*)g.A + (size_t)cur.pm * tstepA; const char* cB = (const char*)g.Bt + (size_t)cur.pn * tstepB;
    S.a_ready(cur);
    if constexpr (SP2) {
        PG8_STAGE(PG8_SB(0, 0), cB, voffB); PG8_STAGE(PG8_SB(0, 1), cB + hstepB, voffB); PG8_STAGE(PG8_SA(0, 0), cA, voffA); PG8_STAGE(PG8_SA(0, 1), cA + hstepA, voffA);
        if (wr == 1) PG8_BAR;
        PG8_WAIT_V(2); PG8_BAR;
        PG8_STAGE(PG8_SB(1, 0), cB + kstepB, voffB); PG8_STAGE(PG8_SA(1, 0), cA + kstepA, voffA); PG8_STAGE(PG8_SB(1, 1), cB + hstepB + kstepB, voffB);
        PG8_WAIT_V(6); PG8_BAR;
    } else {
        PG8_STAGE(PG8_SB(0, 0), cB, voffB); PG8_STAGE(PG8_SA(0, 0), cA, voffA); PG8_STAGE(PG8_SB(0, 1), cB + hstepB, voffB); PG8_STAGE(PG8_SA(0, 1), cA + hstepA, voffA);
        if (wr == 1) PG8_BAR;
        PG8_WAIT_V(4); PG8_BAR;
        PG8_STAGE(PG8_SB(1, 0), cB + kstepB, voffB); PG8_STAGE(PG8_SA(1, 0), cA + kstepA, voffA); PG8_STAGE(PG8_SB(1, 1), cB + hstepB + kstepB, voffB);
        PG8_WAIT_V(6); PG8_BAR;
    }
    for (;;) {
        const bool has_next = S.next(ui + 1, nxt);
        const char* nA = has_next ? (const char*)g.A + (size_t)nxt.pm * tstepA : cA; const char* nB = has_next ? (const char*)g.Bt + (size_t)nxt.pn * tstepB : cB;
        for (int t = 0; t < nt; t += 2) {
            const bool last = (t == nt - 2);
            const char* a1 = cA + (size_t)(t + 1) * kstepA;
            const char* a2 = last ? nA : cA + (size_t)(t + 2) * kstepA; const char* b2 = last ? nB : cB + (size_t)(t + 2) * kstepB;
            const char* a3 = a2 + kstepA; const char* b3 = b2 + kstepB;
            if (last && has_next) S.a_ready(nxt);
            if constexpr (SP2) {
            PG8_LDB(B0, 0, 0); PG8_LDB(B1, 0, 1); PG8_SCHED; PG8_LDA(At, 0, 0); PG8_STAGE(PG8_SA(1, 1), a1 + hstepA, voffA);
            PG8_WAIT_V(8); PG8_WAIT_L(0); PG8_BAR; PG8_MMA(0, 0, At, B0); PG8_MMA(0, 1, At, B1); PG8_BAR; PG8_SCHED;
            PG8_LDA(At, 0, 1); PG8_STAGE(PG8_SB(0, 0), b2, voffB); PG8_STAGE(PG8_SB(0, 1), b2 + hstepB, voffB); PG8_STAGE(PG8_SA(0, 0), a2, voffA);
            PG8_WAIT_V(8); PG8_WAIT_L(0); PG8_BAR; PG8_MMA(1, 0, At, B0); PG8_MMA(1, 1, At, B1); PG8_BAR; PG8_SCHED;
            PG8_LDB(B0, 1, 0); PG8_LDB(B1, 1, 1); PG8_SCHED; PG8_LDA(At, 1, 0); PG8_STAGE(PG8_SA(0, 1), a2 + hstepA, voffA);
            PG8_WAIT_V(8); PG8_WAIT_L(0); PG8_BAR; PG8_MMA(0, 0, At, B0); PG8_MMA(0, 1, At, B1); PG8_BAR; PG8_SCHED;
            PG8_LDA(At, 1, 1); PG8_STAGE(PG8_SB(1, 0), b3, voffB); PG8_STAGE(PG8_SB(1, 1), b3 + hstepB, voffB); PG8_STAGE(PG8_SA(1, 0), a3, voffA);
            PG8_WAIT_V(8); PG8_WAIT_L(0); PG8_BAR; PG8_MMA(1, 0, At, B0); PG8_MMA(1, 1, At, B1); PG8_BAR; PG8_SCHED;
            } else {
            PG8_LDB(B0, 0, 0); PG8_SCHED; PG8_LDA(At, 0, 0); PG8_STAGE(PG8_SA(1, 1), a1 + hstepA, voffA);
            PG8_WAIT_L(8); PG8_BAR; PG8_WAIT_L(0); PG8_MMA(0, 0, At, B0); PG8_BAR; PG8_SCHED;
            PG8_LDB(B1, 0, 1); PG8_STAGE(PG8_SB(0, 0), b2, voffB);
            PG8_BAR; PG8_WAIT_L(0); PG8_MMA(0, 1, At, B1); PG8_BAR;
            PG8_LDA(At, 0, 1); PG8_STAGE(PG8_SA(0, 0), a2, voffA);
            PG8_BAR; PG8_WAIT_L(0); PG8_MMA(1, 0, At, B0); PG8_BAR; PG8_SCHED;
            PG8_STAGE(PG8_SB(0, 1), b2 + hstepB, voffB);
            PG8_WAIT_V(6); PG8_BAR; PG8_MMA(1, 1, At, B1); PG8_BAR;
            PG8_LDB(B0, 1, 0); PG8_SCHED; PG8_LDA(At, 1, 0); PG8_STAGE(PG8_SA(0, 1), a2 + hstepA, voffA);
            PG8_WAIT_L(8); PG8_BAR; PG8_WAIT_L(0); PG8_MMA(0, 0, At, B0); PG8_BAR; PG8_SCHED;
            PG8_LDB(B1, 1, 1); PG8_STAGE(PG8_SB(1, 0), b3, voffB);
            PG8_BAR; PG8_WAIT_L(0); PG8_MMA(0, 1, At, B1); PG8_BAR;
            PG8_LDA(At, 1, 1); PG8_STAGE(PG8_SA(1, 0), a3, voffA);
            PG8_BAR; PG8_WAIT_L(0); PG8_MMA(1, 0, At, B0); PG8_BAR; PG8_SCHED;
            PG8_STAGE(PG8_SB(1, 1), b3 + hstepB, voffB);
            PG8_WAIT_V(6); PG8_BAR; PG8_MMA(1, 1, At, B1); PG8_BAR;
            }
        }
        if constexpr (ALIGN_EPI) { if (wr == 0) PG8_BAR; }
        E(acc, cur, wr, wc, fr, fq); S.done(cur);
        if (!has_next) break;
#pragma unroll
        for (int a = 0; a < 2; ++a)
#pragma unroll
            for (int b = 0; b < 2; ++b)
#pragma unroll
                for (int m = 0; m < 4; ++m)
#pragma unroll
                    for (int n = 0; n < 2; ++n) acc[a][b][m][n] = (f32x4){0.f, 0.f, 0.f, 0.f};
        cur = nxt; cA = nA; cB = nB; ++ui;
        if constexpr (ALIGN_EPI) { if (wr == 1) PG8_BAR; }
    }
    PG8_WAIT_V(0);
    if constexpr (!ALIGN_EPI) { if (wr == 0) PG8_BAR; }
    PG8_BAR;
#undef PG8_SA
#undef PG8_SB
#undef PG8_STAGE
#undef PG8_LDA
#undef PG8_LDB
#undef PG8_MMA
#undef PG8_WAIT_V
#undef PG8_WAIT_L
#undef PG8_BAR
#undef PG8_SCHED
}
}
using pg8::Unit;

typedef f32x4 Acc[2][2][4][2];
__device__ __forceinline__ float red_fq(float s) {
    s += __int_as_float(__builtin_amdgcn_ds_swizzle(__float_as_int(s), 0x401F));
    auto rr = __builtin_amdgcn_permlane32_swap(__float_as_uint(s), __float_as_uint(s), false, false);
    return __uint_as_float(rr[0]) + __uint_as_float(rr[1]);
}
__device__ __forceinline__ float ss4(f32x4 a) { return (a[0] * a[0] + a[1] * a[1]) + (a[2] * a[2] + a[3] * a[3]); }
__device__ __forceinline__ u32x4 pack8(f32x4 a, f32x4 b) { u32x4 w; w.x = pg8::cvt_pk_bf16(a[0], a[1]); w.y = pg8::cvt_pk_bf16(a[2], a[3]); w.z = pg8::cvt_pk_bf16(b[0], b[1]); w.w = pg8::cvt_pk_bf16(b[2], b[3]); return w; }
__device__ __forceinline__ f32x4 ld4(const float* p) { return *(const f32x4*)p; }
__device__ __forceinline__ float logsig(float z) { return fminf(z, 0.f) - log1pf(expf(-fabsf(z))); }

struct EpiFoxIn {
    static constexpr bool PERM = true;
    bf16 *Q, *QM; size_t qkv_stride; float *qss, *kss, *mqss, *logf;
    const float *gq, *gk, *gmq, *gmk, *bfg; const LAS float* rtab; int rbase;
    __device__ __forceinline__ void operator()(const Acc& acc, const Unit& u, int wr, int wc, int fr, int fq) const {
        const int pn = u.pn, rowb = u.pm * 256 + wr * 64 + fr, cw = wc * 32 + 8 * fq;
        if (pn < 36) {
            const int sec = pn / 12, hp = pn - sec * 12;
            bf16* base = Q + (size_t)sec * qkv_stride; float* ssb = sec ? kss : qss;
            f32x4 g0 = (f32x4){1.f, 1.f, 1.f, 1.f}, g1 = g0;
            if (sec == 0) { g0 = ld4(gq + cw) * ld4(gk + cw); g1 = ld4(gq + cw + 4) * ld4(gk + cw + 4); }
#pragma unroll
            for (int ai = 0; ai < 2; ++ai)
#pragma unroll
                for (int m = 0; m < 4; ++m) { const int row = rowb + ai * 128 + m * 16; const float rs = rtab[row - rbase];
#pragma unroll
                    for (int bj = 0; bj < 2; ++bj) { const int head = 2 * hp + bj; f32x4 v0 = acc[ai][bj][m][0] * rs, v1 = acc[ai][bj][m][1] * rs;
                        if (sec < 2) { const float s = red_fq(ss4(v0) + ss4(v1)); if (fq == 0) ssb[((size_t)row * NH + head) * 4 + wc] = s; }
                        if (sec == 0) { v0 = v0 * g0; v1 = v1 * g1; }
                        *(u32x4*)(base + ((size_t)head * T + row) * 128 + cw) = pack8(v0, v1); } }
        } else if (pn < 40) {
            const int mh = pn - 36; f32x4 g[2][2];
#pragma unroll
            for (int bj = 0; bj < 2; ++bj) { const int d = 128 * bj + cw; g[bj][0] = ld4(gmq + d) * ld4(gmk + d); g[bj][1] = ld4(gmq + d + 4) * ld4(gmk + d + 4); }
#pragma unroll
            for (int ai = 0; ai < 2; ++ai)
#pragma unroll
                for (int m = 0; m < 4; ++m) { const int row = rowb + ai * 128 + m * 16; const float rs = rtab[row - rbase];
                    f32x4 v[2][2]; float s = 0.f;
#pragma unroll
                    for (int bj = 0; bj < 2; ++bj) { v[bj][0] = acc[ai][bj][m][0] * rs; v[bj][1] = acc[ai][bj][m][1] * rs; s += ss4(v[bj][0]) + ss4(v[bj][1]); }
                    s = red_fq(s); if (fq == 0) mqss[((size_t)row * NMH + mh) * 4 + wc] = s;
#pragma unroll
                    for (int bj = 0; bj < 2; ++bj) *(u32x4*)(QM + ((size_t)mh * T + row) * 256 + 128 * bj + cw) = pack8(v[bj][0] * g[bj][0], v[bj][1] * g[bj][1]); }
        } else {
            if (wc == 0 && fq < 3) {
                const f32x4 b0 = ld4(bfg + 8 * fq), b1 = ld4(bfg + 8 * fq + 4);
#pragma unroll
                for (int ai = 0; ai < 2; ++ai)
#pragma unroll
                    for (int m = 0; m < 4; ++m) { const int row = rowb + ai * 128 + m * 16; const float rs = rtab[row - rbase];
                        const f32x4 v0 = acc[ai][0][m][0] * rs + b0, v1 = acc[ai][0][m][1] * rs + b1;
                        float* lp = logf + ((size_t)(row >> 12) * NH + 8 * fq) * SEQ + (row & (SEQ - 1));
#pragma unroll
                        for (int e = 0; e < 4; ++e) { lp[(size_t)e * SEQ] = logsig(v0[e]); lp[(size_t)(e + 4) * SEQ] = logsig(v1[e]); } }
            }
        }
    }
};
__device__ __forceinline__ void rope8(f32x4& v0, f32x4& v1, const f32x4 g1, const f32x4 g2, const f32x4 cs, const f32x4 sn) {
    const f32x4 x1 = v0 * g1, x2 = v1 * g2; v0 = x1 * cs - x2 * sn; v1 = x2 * cs + x1 * sn;
}
struct EpiMlaIn {
    static constexpr bool PERM = true;
    bf16 *CQ, *CKV, *QM, *RK; float *cqss, *ckvss, *mqss, *krss;
    const float *gmq, *gmk, *gkn  , *cosT, *sinT; const LAS float* rtab; int rbase;
    __device__ __forceinline__ void operator()(const Acc& acc, const Unit& u, int wr, int wc, int fr, int fq) const {
        const int pn = u.pn, rowb = u.pm * 256 + wr * 64 + fr, cw = wc * 32 + 8 * fq;
        if (pn < 8) {
            const bool isq = pn < 6; bf16* base = isq ? CQ : CKV; const int ld = isq ? QLR : KVLR, cb = isq ? pn * 256 : (pn - 6) * 256;
            float* ssb = isq ? cqss + pn * 4 + wc : ckvss + (pn - 6) * 4 + wc; const int sst = isq ? 24 : 8;
#pragma unroll
            for (int ai = 0; ai < 2; ++ai)
#pragma unroll
                for (int m = 0; m < 4; ++m) { const int row = rowb + ai * 128 + m * 16; const float rs = rtab[row - rbase];
                    f32x4 v[2][2]; float s = 0.f;
#pragma unroll
                    for (int bj = 0; bj < 2; ++bj) { v[bj][0] = acc[ai][bj][m][0] * rs; v[bj][1] = acc[ai][bj][m][1] * rs; s += ss4(v[bj][0]) + ss4(v[bj][1]); }
                    s = red_fq(s); if (fq == 0) ssb[(size_t)row * sst] = s;
#pragma unroll
                    for (int bj = 0; bj < 2; ++bj) *(u32x4*)(base + act_off(row, cb + 128 * bj + cw, T, ld)) = pack8(v[bj][0], v[bj][1]); }
        } else if (pn < 12) {
            const int mh = pn - 8; f32x4 g[2][2];
#pragma unroll
            for (int bj = 0; bj < 2; ++bj) { const int d = 128 * bj + cw; g[bj][0] = ld4(gmq + d) * ld4(gmk + d); g[bj][1] = ld4(gmq + d + 4) * ld4(gmk + d + 4); }
#pragma unroll
            for (int ai = 0; ai < 2; ++ai)
#pragma unroll
                for (int m = 0; m < 4; ++m) { const int row = rowb + ai * 128 + m * 16; const float rs = rtab[row - rbase];
                    f32x4 v[2][2]; float s = 0.f;
#pragma unroll
                    for (int bj = 0; bj < 2; ++bj) { v[bj][0] = acc[ai][bj][m][0] * rs; v[bj][1] = acc[ai][bj][m][1] * rs; s += ss4(v[bj][0]) + ss4(v[bj][1]); }
                    s = red_fq(s); if (fq == 0) mqss[((size_t)row * NMH + mh) * 4 + wc] = s;
#pragma unroll
                    for (int bj = 0; bj < 2; ++bj) *(u32x4*)(QM + ((size_t)mh * T + row) * 256 + 128 * bj + cw) = pack8(v[bj][0] * g[bj][0], v[bj][1] * g[bj][1]); }
        } else {
            if (wc < 2) {
                const int i0 = 16 * wc + 4 * fq; const f32x4 g1 = ld4(gkn + 128 + i0), g2 = ld4(gkn + 160 + i0);
#pragma unroll
                for (int ai = 0; ai < 2; ++ai)
#pragma unroll
                    for (int m = 0; m < 4; ++m) { const int row = rowb + ai * 128 + m * 16; const float rs = rtab[row - rbase];
                        f32x4 v0 = acc[ai][0][m][0] * rs, v1 = acc[ai][0][m][1] * rs;
                        const float s = red_fq(ss4(v0) + ss4(v1)); if (fq == 0) krss[(size_t)row * 2 + wc] = s;
                        rope8(v0, v1, g1, g2, ld4(cosT + (size_t)row * 32 + i0), ld4(sinT + (size_t)row * 32 + i0));
                        *(u32x4*)(RK + (size_t)row * 64 + 32 * wc + 8 * fq) = pack8(v0, v1); }
            }
        }
    }
};
struct EpiQB {
    static constexpr bool PERM = true;
    bf16 *QN, *QR; float* qss; const float *gq, *gk, *cosT, *sinT; const LAS float* rtab; int rbase;
    __device__ __forceinline__ void operator()(const Acc& acc, const Unit& u, int wr, int wc, int fr, int fq) const {
        const int pn = u.pn, rowb = u.pm * 256 + wr * 64 + fr, cw = wc * 32 + 8 * fq;
        if (pn < 12) {
            const f32x4 g0 = ld4(gq + cw) * ld4(gk + cw), g1 = ld4(gq + cw + 4) * ld4(gk + cw + 4);
#pragma unroll
            for (int ai = 0; ai < 2; ++ai)
#pragma unroll
                for (int m = 0; m < 4; ++m) { const int row = rowb + ai * 128 + m * 16; const float rs = rtab[row - rbase];
#pragma unroll
                    for (int bj = 0; bj < 2; ++bj) { const int head = 2 * pn + bj; const f32x4 v0 = acc[ai][bj][m][0] * rs, v1 = acc[ai][bj][m][1] * rs;
                        const float s = red_fq(ss4(v0) + ss4(v1)); if (fq == 0) qss[((size_t)row * NH + head) * 8 + wc] = s;
                        *(u32x4*)(QN + ((size_t)head * T + row) * 128 + cw) = pack8(v0 * g0, v1 * g1); } }
        } else {
            const int t = pn - 12, wl = wc & 1, i0 = 16 * wl + 4 * fq; const f32x4 g1 = ld4(gq + 128 + i0), g2 = ld4(gq + 160 + i0);
#pragma unroll
            for (int ai = 0; ai < 2; ++ai)
#pragma unroll
                for (int m = 0; m < 4; ++m) { const int row = rowb + ai * 128 + m * 16; const float rs = rtab[row - rbase];
                    const f32x4 cs = ld4(cosT + (size_t)row * 32 + i0), sn = ld4(sinT + (size_t)row * 32 + i0);
#pragma unroll
                    for (int bj = 0; bj < 2; ++bj) { const int head = 4 * t + 2 * bj + (wc >> 1); f32x4 v0 = acc[ai][bj][m][0] * rs, v1 = acc[ai][bj][m][1] * rs;
                        const float s = red_fq(ss4(v0) + ss4(v1)); if (fq == 0) qss[((size_t)row * NH + head) * 8 + 4 + wl] = s;
                        rope8(v0, v1, g1, g2, cs, sn);
                        *(u32x4*)(QR + ((size_t)head * T + row) * 64 + 32 * wl + 8 * fq) = pack8(v0, v1); } }
        }
    }
};
struct EpiKVB {
    static constexpr bool PERM = true;
    bf16 *KN, *VV; float* kss; const LAS float* rtab; int rbase;
    __device__ __forceinline__ void operator()(const Acc& acc, const Unit& u, int wr, int wc, int fr, int fq) const {
        const int pn = u.pn, rowb = u.pm * 256 + wr * 64 + fr, cw = wc * 32 + 8 * fq; const bool isk = pn < 12; const int hp = isk ? pn : pn - 12; bf16* base = isk ? KN : VV;
#pragma unroll
        for (int ai = 0; ai < 2; ++ai)
#pragma unroll
            for (int m = 0; m < 4; ++m) { const int row = rowb + ai * 128 + m * 16; const float rs = rtab[row - rbase];
#pragma unroll
                for (int bj = 0; bj < 2; ++bj) { const int head = 2 * hp + bj; const f32x4 v0 = acc[ai][bj][m][0] * rs, v1 = acc[ai][bj][m][1] * rs;
                    if (isk) { const float s = red_fq(ss4(v0) + ss4(v1)); if (fq == 0) kss[((size_t)row * NH + head) * 4 + wc] = s; }
                    *(u32x4*)(base + ((size_t)head * T + row) * 128 + cw) = pack8(v0, v1); } }
    }
};
struct EpiMemKV {
    static constexpr bool PERM = true;
    bf16 *MK, *MV; float* mkss; const LAS float* rtab; int rbase;
    __device__ __forceinline__ void operator()(const Acc& acc, const Unit& u, int wr, int wc, int fr, int fq) const {
        const int pn = u.pn, rowb = u.pm * 256 + wr * 64 + fr, cw = wc * 32 + 8 * fq; const bool isk = pn < 4; const int mh = isk ? pn : pn - 4; bf16* base = isk ? MK : MV;
#pragma unroll
        for (int ai = 0; ai < 2; ++ai)
#pragma unroll
            for (int m = 0; m < 4; ++m) { const int row = rowb + ai * 128 + m * 16; const float rs = rtab[row - rbase];
                f32x4 v[2][2]; float s = 0.f;
#pragma unroll
                for (int bj = 0; bj < 2; ++bj) { v[bj][0] = acc[ai][bj][m][0] * rs; v[bj][1] = acc[ai][bj][m][1] * rs; s += ss4(v[bj][0]) + ss4(v[bj][1]); }
                if (isk) { s = red_fq(s); if (fq == 0) mkss[((size_t)mh * MT + row) * 4 + wc] = s; }
#pragma unroll
                for (int bj = 0; bj < 2; ++bj) *(u32x4*)(base + (size_t)row * 1024 + mh * 256 + 128 * bj + cw) = pack8(v[bj][0], v[bj][1]); }
    }
};
__device__ __forceinline__ f32x4 bf2f_lo(u32x2 w) { return (f32x4){__uint_as_float(w.x << 16), __uint_as_float(w.x & 0xffff0000u), __uint_as_float(w.y << 16), __uint_as_float(w.y & 0xffff0000u)}; }
template <bool LAST> struct EpiRes {
    static constexpr bool PERM = true;
    const bf16* XBr; bf16* XB; float* out; float* rss;
    __device__ __forceinline__ void operator()(const Acc& acc, const Unit& u, int wr, int wc, int fr, int fq) const {
        const int pn = u.pn, rowb = u.pm * 256 + wr * 64 + fr, cw = wc * 32 + 8 * fq;
#pragma unroll
        for (int ai = 0; ai < 2; ++ai)
#pragma unroll
            for (int m = 0; m < 4; ++m) { const int row = rowb + ai * 128 + m * 16; float s = 0.f;
#pragma unroll
                for (int bj = 0; bj < 2; ++bj) { const size_t o = (size_t)row * DM + pn * 256 + 128 * bj + cw, ob = act_off(row, pn * 256 + 128 * bj + cw, T, DM);
                    const u32x4 xr = *(const u32x4*)(XBr + ob);
                    const f32x4 v0 = bf2f_lo((u32x2){xr.x, xr.y}) + acc[ai][bj][m][0], v1 = bf2f_lo((u32x2){xr.z, xr.w}) + acc[ai][bj][m][1];
                    if (LAST) { *(f32x4*)(out + o) = v0; *(f32x4*)(out + o + 4) = v1; }
                    else { s += ss4(v0) + ss4(v1); *(u32x4*)(XB + ob) = pack8(v0, v1); } }
                if (!LAST) { s = red_fq(s); if (fq == 0) rss[(size_t)row * 64 + pn * 4 + wc] = s; } }
    }
};
struct EpiUp {
    static constexpr bool PERM = true;
    bf16* HID; const LAS float* rtab; int rbase;
    __device__ __forceinline__ void operator()(const Acc& acc, const Unit& u, int wr, int wc, int fr, int fq) const {
        const int pn = u.pn, rowb = u.pm * 256 + wr * 64 + fr, cw = wc * 32 + 8 * fq;
#pragma unroll
        for (int ai = 0; ai < 2; ++ai)
#pragma unroll
            for (int m = 0; m < 4; ++m) { const int row = rowb + ai * 128 + m * 16; const float rs = rtab[row - rbase];
#pragma unroll
                for (int bj = 0; bj < 2; ++bj) { f32x4 v0 = acc[ai][bj][m][0] * rs, v1 = acc[ai][bj][m][1] * rs;
#pragma unroll
                    for (int e = 0; e < 4; ++e) { const float a = fmaxf(v0[e], 0.f), b = fmaxf(v1[e], 0.f); v0[e] = a * a; v1[e] = b * b; }
                    { const int col = pn * 256 + 128 * bj + cw;
                      *(u32x4*)(HID + (HID_BLK ? ((size_t)(col >> 6) * T + row) * 64 + (col & 63) : (size_t)row * FF + col)) = pack8(v0, v1); } } }
    }
};

namespace att {
constexpr int SHM_V = 64 * 128 * 2;
constexpr int L_V = 0, L_K = 49152, L_WS = 155648, L_SC = 157696;
constexpr int l_rk(int dk) { return L_K + 3 * 64 * dk * 2; }
constexpr int l_dl(int dk) { return l_rk(dk) + 16384; }
static_assert(l_dl(128) + 16384 <= L_WS && l_rk(192) + 16384 <= L_WS && l_rk(256) + 1024 <= L_WS, "attention LDS map");
__device__ __forceinline__ int v_st(int k, int c) { const int kk = (k & ~0xC) | ((k & 4) << 1) | ((k & 8) >> 1); return ((kk >> 3) * 4 + (c >> 5)) * 512 + ((kk & 7) * 32 + (c & 31)) * 2; }
__device__ __forceinline__ int v_rd_base(int lane) { return ((lane & 3) << 3) | (((lane >> 2) & 3) << 6) | (((lane >> 4) & 1) << 5) | (((lane >> 5) & 1) << 8); }
constexpr int v_rd_off(int d0, int ks, int half) { return d0 * 512 + ks * 4096 + half * 2048; }
__device__ __forceinline__ int crow(int r, int hi) { return (r & 3) + 8 * (r >> 2) + 4 * hi; }
__device__ __forceinline__ unsigned cvtpk(float lo, float hi) { return pg8::cvt_pk_bf16(lo, hi); }
#define SBAR() __builtin_amdgcn_sched_barrier(0)
__device__ __forceinline__ float fmul_s(float a, float b) { return a * b; }
__device__ __forceinline__ float fadd_s(float a, float b) { return a + b; }
__device__ __forceinline__ float fsub_s(float a, float b) { return a - b; }
__device__ __forceinline__ float ffma_s(float a, float b, float c) { return __builtin_fmaf(a, b, c); }

struct Blk {
    const bf16 *Qa, *Qb;
    const bf16 *Ka, *Kb;
    const bf16* V;
    bf16* O; int orow0, ocol0;
    const float* qssp;
    int nkt;
    int nrun;
    int qpos0;
};
template <int QPA, int QPB, int KPA, int KPB, int VP, int QSTR> struct Pitch { static constexpr int qpa = QPA, qpb = QPB, kpa = KPA, kpb = KPB, vp = VP, qstr = QSTR; };

template <int DK, int DKA, int NQS, bool CAUSAL, bool BIAS, bool QREG, bool REV, class P>
__device__ __forceinline__ void attn_block(char* lds, const Blk& B, const int wv) {
    constexpr int SWA = (DKA == 128) ? 15 : 7, NKBP = (SWA + 1) / 2;
    constexpr int RSA = DKA * 2, RSB = 128, SHM_K = 64 * DK * 2, KB_OFF = 64 * RSA, NPA = DKA / 64, ND = DK / 16, NDA = DKA / 16; constexpr bool HASB = DK > DKA;
    constexpr int NP = NPA + (HASB ? 1 : 0) + 2;
    static_assert(!HASB || DK - DKA == 64, "region B is 64 dims");
    int tid = tid_of(wv); asm volatile("" : "+v"(tid));
    const int wid = __builtin_amdgcn_readfirstlane(tid >> 6), lane = tid & 63, r32 = lane & 31, hi = lane >> 5, grp = wid >> 2;
    LAS unsigned char* ldsl = (LAS unsigned char*)lds;
    char* V_lds = lds + L_V; char* K_lds = lds + L_K;
    const float* DL = (const float*)(lds + l_dl(DK)); const float* RKt = (const float*)(lds + l_rk(DK));
    const int qrow = wid * 32 + r32;
    const unsigned qoa = (unsigned)(qrow * P::qpa + hi * 8) * 2u, qob = (unsigned)(qrow * P::qpb + hi * 8) * 2u;
#define QFRAG(d0) ((d0) < NDA ? *(const bf16x8*)((const char*)B.Qa + (qoa + (d0) * 32)) : *(const bf16x8*)((const char*)B.Qb + (qob + ((d0) - NDA) * 32)))
    float rq;
    { const float* qp = B.qssp + (size_t)qrow * P::qstr; const f32x4 a = ld4(qp); float s = (a[0] + a[1]) + (a[2] + a[3]);
      if (NQS == 6) { const f32x2 b = *(const f32x2*)(qp + 4); s += b[0] + b[1]; }
      rq = rsqrtf(s * (1.f / DK) + EPS); }
    bf16x8 qr[QREG ? ND : 1];
    if (QREG) {
#pragma unroll
        for (int d0 = 0; d0 < ND; ++d0) { const bf16x8 raw = QFRAG(d0); const u32x4 w = *reinterpret_cast<const u32x4*>(&raw); u32x4 o_;
#pragma unroll
            for (int e = 0; e < 4; ++e) o_[e] = cvtpk(__uint_as_float(w[e] << 16) * rq, __uint_as_float(w[e] & 0xffff0000u) * rq);
            qr[QREG ? d0 : 0] = *reinterpret_cast<const bf16x8*>(&o_); } }
    const float rqs = QREG ? 1.f : rq;
    const int qlo = B.qpos0 + wid * 32, qpos = qlo + r32;
    constexpr int NKA = 2 * NPA, NKB = HASB ? 2 : 0, NK_ = NKA + NKB, NVP = 4;
    const int lw = wid & 3;
    static_assert((4096 / RSA) % (SWA + 1) == 0 && (4096 / RSB) % 8 == 0, "piece stride keeps the swizzle phase");
    unsigned kva0, kvb0 = 0u, vva0;
    { const int b = lw * 1024 + lane * 16, krow = b / RSA, x = b % RSA, kc = (x ^ ((krow & SWA) << 4)) >> 4; kva0 = (unsigned)(krow * P::kpa + kc * 8) * 2u; }
    if (HASB) { const int b = lw * 1024 + lane * 16, krow = b / RSB, x = b % RSB, kc = (x ^ ((krow & 7) << 4)) >> 4; kvb0 = (unsigned)(krow * P::kpb + kc * 8) * 2u; }
    { const int b = lw * 1024 + lane * 16, sub = b >> 9, w = (b & 511) >> 1, kk = (sub >> 2) * 8 + (w >> 5), c = (sub & 3) * 32 + (w & 31);
      const int k = (kk & ~0xC) | ((kk & 4) << 1) | ((kk & 8) >> 1); vva0 = (unsigned)(k * P::vp + c) * 2u; }
    constexpr unsigned PSA = (unsigned)((4096 / RSA) * P::kpa) * 2u, PSB = (unsigned)((4096 / RSB) * P::kpb) * 2u, PSV = (unsigned)(16 * P::vp) * 2u;
    const unsigned tsa = (unsigned)(64 * P::kpa) * 2u, tsb = (unsigned)(64 * P::kpb) * 2u, tsv = (unsigned)(64 * P::vp) * 2u;
    const int vb0 = (int)(uintptr_t)V_lds + v_rd_base(lane);
#define DMA16(gp, ldsoff) __builtin_amdgcn_global_load_lds((const unsigned*)(gp), (LAS unsigned*)(ldsl + (ldsoff)), 16, 0, 0)
#define LOADK(t_, bf) do { _Pragma("unroll") for (int i = 0; i < NKA; ++i) DMA16((const char*)B.Ka + ((size_t)(unsigned)(t_) * tsa + i * PSA) + kva0, L_K + (bf) * SHM_K + (lw + 4 * i) * 1024); \
        if (HASB) { _Pragma("unroll") for (int i = 0; i < 2; ++i) DMA16((const char*)B.Kb + ((size_t)(unsigned)(t_) * tsb + i * PSB) + kvb0, L_K + (bf) * SHM_K + KB_OFF + (lw + 4 * i) * 1024); } } while (0)
#define LOADV(t_, bf) do { _Pragma("unroll") for (int i = 0; i < NVP; ++i) DMA16((const char*)B.V + ((size_t)(unsigned)(t_) * tsv + i * PSV) + vva0, L_V + (bf) * SHM_V + (lw + 4 * i) * 1024); } while (0)
#define VMWAIT(n) asm volatile("s_waitcnt vmcnt(%0)" :: "n"(n) : "memory")
#define WGBAR() do { asm volatile("" ::: "memory"); __builtin_amdgcn_s_barrier(); asm volatile("" ::: "memory"); } while (0)
    constexpr float DEFER_THR = 8.f;
    float m_reg = 0.f, l_reg = 0.f; f32x16 o[4] = {};
    const int nkt = B.nkt, nrun = B.nrun;
#define KT(t_) (REV ? nkt - 1 - (t_) : (t_))
    if (!grp) { LOADK(KT(0), 0); LOADV(KT(0), 0); LOADK(KT(1), 1); LOADV(KT(1), 1); VMWAIT(NVP + NK_ + NVP); }
    WGBAR();
    if (grp) WGBAR();
#define SCALE(P, kk_) do { _Pragma("unroll") for (int g = 0; g < 4; ++g) { \
            f32x4 rk_ = ld4(RKt + (kk_) + 8 * g); if (!QREG) { _Pragma("unroll") for (int j = 0; j < 4; ++j) rk_[j] = fmul_s(rk_[j], rqs); } \
            if (BIAS) { const f32x4 nd_ = ld4(DL + (kk_) + 8 * g) - m_reg; \
                _Pragma("unroll") for (int j = 0; j < 4; ++j) P[4 * g + j] = ffma_s(P[4 * g + j], rk_[j], nd_[j]); } \
            else { const float nm_ = -m_reg; _Pragma("unroll") for (int j = 0; j < 4; ++j) P[4 * g + j] = ffma_s(P[4 * g + j], rk_[j], nm_); } } } while (0)
#define MASK1(P, r_, c_) asm volatile("v_cmp_lt_i32 vcc, %1, %2\n\tv_cndmask_b32 %0, %0, %3, vcc" : "+v"(P[r_]) : "v"(dqk), "n"(c_), "v"(NEG) : "vcc")
#define TRRD(dst, off) asm volatile("ds_read_b64_tr_b16 %0, %1 offset:%2" : "=&v"(dst) : "v"(vb0), "i"(off) : "memory")
#define LGK(n) do { asm volatile("s_waitcnt lgkmcnt(" #n ")" ::: "memory"); SBAR(); } while (0)
#define VLD(S, VB, ks) do { constexpr int b_ = (VB) * SHM_V + (ks) * 4096; \
        TRRD(S##l0, b_); TRRD(S##h0, b_ + 2048); TRRD(S##l1, b_ + 512); TRRD(S##h1, b_ + 2560); TRRD(S##l2, b_ + 1024); TRRD(S##h2, b_ + 3072); TRRD(S##l3, b_ + 1536); TRRD(S##h3, b_ + 3584); } while (0)
#define MM(S, d0, PA) o[d0] = __builtin_amdgcn_mfma_f32_32x32x16_bf16((bf16x8){S##l##d0[0], S##l##d0[1], S##l##d0[2], S##l##d0[3], S##h##d0[0], S##h##d0[1], S##h##d0[2], S##h##d0[3]}, PA, o[d0], 0, 0, 0)
#define EXS(P, B_, j, CV) do { P[B_ + 2 * (j)] = __builtin_amdgcn_exp2f(P[B_ + 2 * (j)]); P[B_ + 2 * (j) + 1] = __builtin_amdgcn_exp2f(P[B_ + 2 * (j) + 1]); \
        ps += P[B_ + 2 * (j)] + P[B_ + 2 * (j) + 1]; CV = cvtpk(P[B_ + 2 * (j)], P[B_ + 2 * (j) + 1]); } while (0)
#define PKQ(OUT) do { auto r0 = __builtin_amdgcn_permlane32_swap(a0, b0, false, false); auto r1 = __builtin_amdgcn_permlane32_swap(a1, b1, false, false); \
        u32x4 w = {r0[0], r1[0], r0[1], r1[1]}; OUT = *reinterpret_cast<bf16x8*>(&w); } while (0)
#define EXP2(P, i0) do { P[i0] = __builtin_amdgcn_exp2f(P[i0]); P[(i0) + 1] = __builtin_amdgcn_exp2f(P[(i0) + 1]); } while (0)
#define ACC2(P, i0, CV) do { ps += P[i0]; ps += P[(i0) + 1]; CV = cvtpk(P[i0], P[(i0) + 1]); } while (0)
#define QBODY(S, PA, P, B_) \
        MM(S, 0, PA); EXP2(P, B_); SBAR(); \
        MM(S, 1, PA); EXP2(P, B_ + 2); ACC2(P, B_, a0); SBAR(); \
        MM(S, 2, PA); EXP2(P, B_ + 4); ACC2(P, B_ + 2, a1); SBAR(); \
        MM(S, 3, PA); EXP2(P, B_ + 6); ACC2(P, B_ + 4, b0); SBAR()
#define QTAIL(P, B_, OUT) do { ACC2(P, B_ + 6, b1); PKQ(OUT); SBAR(); } while (0)
#define KFR(BUF, i_, h_) (*reinterpret_cast<const bf16x8*>((i_) < NDA ? kbp[(i_) % NKBP] + ((i_) / NKBP) * (NKBP * 32) + (h_) * 32 * RSA \
        : K_lds + (BUF) * SHM_K + KB_OFF + (r32 + (h_) * 32) * RSB + (((((i_) - NDA) * 16 + hi * 8) * 2) ^ ((r32 & 7) << 4))))
#define SCALE2(P, RK_, DL_) do { _Pragma("unroll") for (int g = 0; g < 4; ++g) { \
            if (BIAS) { const f32x4 nd_ = DL_[g] - m_reg; _Pragma("unroll") for (int j = 0; j < 4; ++j) P[4 * g + j] = ffma_s(P[4 * g + j], RK_[g][j], nd_[j]); } \
            else { const float nm_ = -m_reg; _Pragma("unroll") for (int j = 0; j < 4; ++j) P[4 * g + j] = ffma_s(P[4 * g + j], RK_[g][j], nm_); } } } while (0)
#define STEP(BUF, t_) do { const int kb_ = KT(t_) * 64; \
        const bool act_ = !(CAUSAL && kb_ > qlo + 31);        \
          \
          \
        bf16x8 qt[QREG ? 1 : ND]; if (!QREG) { _Pragma("unroll") for (int d0 = 0; d0 < ND; ++d0) qt[QREG ? 0 : d0] = QFRAG(d0); asm volatile("" :: "v"(qt[QREG ? 0 : ND - 1]) : "memory"); }     \
        if (!grp && (t_) + 2 < nrun) LOADK(KT((t_) + 2), ((BUF) + 2) % 3); \
        f32x16 p0 = {}, p1 = {}; SBAR(); \
        if (act_) { const char* kbp[NKBP]; _Pragma("unroll") for (int dd = 0; dd < NKBP; ++dd) kbp[dd] = K_lds + (BUF) * SHM_K + r32 * RSA + (((dd * 16 + hi * 8) * 2) ^ ((r32 & SWA) << 4)); \
          if constexpr (QREG) { \
            \
            \
            \
          constexpr int RD = 8; \
          bf16x8 ka_[RD], kb2_[RD]; f32x4 rkA[4], rkB[4], dlA[4] = {}, dlB[4] = {}; const int kk0_ = kb_ + 4 * hi; \
          _Pragma("unroll") for (int s_ = 0; s_ < RD; ++s_) { ka_[s_] = KFR(BUF, s_, 0); kb2_[s_] = KFR(BUF, s_, 1); } \
          SBAR(); \
          _Pragma("unroll") for (int d0 = 0; d0 < ND; ++d0) { \
            p0 = __builtin_amdgcn_mfma_f32_32x32x16_bf16(ka_[d0 % RD], qr[QREG ? d0 : 0], p0, 0, 0, 0); p1 = __builtin_amdgcn_mfma_f32_32x32x16_bf16(kb2_[d0 % RD], qr[QREG ? d0 : 0], p1, 0, 0, 0); \
            if (d0 + RD < ND) { ka_[d0 % RD] = KFR(BUF, d0 + RD, 0); kb2_[d0 % RD] = KFR(BUF, d0 + RD, 1); } \
            if (d0 == ND - 4) { _Pragma("unroll") for (int g = 0; g < 4; ++g) { rkA[g] = ld4(RKt + kk0_ + 8 * g); if (BIAS) dlA[g] = ld4(DL + kk0_ + 8 * g); } } \
            if (d0 == ND - 2) { _Pragma("unroll") for (int g = 0; g < 4; ++g) { rkB[g] = ld4(RKt + kk0_ + 32 + 8 * g); if (BIAS) dlB[g] = ld4(DL + kk0_ + 32 + 8 * g); } } \
            SBAR(); } \
          SCALE2(p0, rkA, dlA); SCALE2(p1, rkB, dlB); \
          } else { \
          _Pragma("unroll") for (int d0 = 0; d0 < NDA; ++d0) { const char* a_ = kbp[d0 % NKBP] + (d0 / NKBP) * (NKBP * 32); \
            const bf16x8 b0_ = *reinterpret_cast<const bf16x8*>(a_), b1_ = *reinterpret_cast<const bf16x8*>(a_ + 32 * RSA); \
            const bf16x8 q_ = QREG ? qr[QREG ? d0 : 0] : qt[QREG ? 0 : d0]; \
            p0 = __builtin_amdgcn_mfma_f32_32x32x16_bf16(b0_, q_, p0, 0, 0, 0); p1 = __builtin_amdgcn_mfma_f32_32x32x16_bf16(b1_, q_, p1, 0, 0, 0); if (!QREG && (d0 & 3) == 3) SBAR(); } \
          if (HASB) { _Pragma("unroll") for (int e = 0; e < 4; ++e) { const char* a_ = K_lds + (BUF) * SHM_K + KB_OFF + r32 * RSB + (((e * 16 + hi * 8) * 2) ^ ((r32 & 7) << 4)); \
            const bf16x8 b0_ = *reinterpret_cast<const bf16x8*>(a_), b1_ = *reinterpret_cast<const bf16x8*>(a_ + 32 * RSB); \
            const bf16x8 q_ = QREG ? qr[QREG ? NDA + e : 0] : qt[QREG ? 0 : NDA + e]; \
            p0 = __builtin_amdgcn_mfma_f32_32x32x16_bf16(b0_, q_, p0, 0, 0, 0); p1 = __builtin_amdgcn_mfma_f32_32x32x16_bf16(b1_, q_, p1, 0, 0, 0); } } \
        SBAR(); SCALE(p0, kb_ + 4 * hi); SCALE(p1, kb_ + 32 + 4 * hi); } } SBAR(); \
        if (!grp) { if ((t_) + 2 < nrun) VMWAIT(2 * NK_ + NVP); else if ((t_) + 1 < nrun) VMWAIT(NK_ + NVP); else VMWAIT(0); }     \
        WGBAR(); \
          \
        if (!grp && (t_) + 2 < nrun) LOADV(KT((t_) + 2), ((BUF) + 2) % 3); \
        if (act_) { \
        if (CAUSAL && kb_ + 63 > qlo) { const float NEG = -__builtin_inff(); const int dqk = qpos - kb_ - 4 * hi; \
            _Pragma("unroll") for (int r = 0; r < 16; ++r) { MASK1(p0, r, (r & 3) + 8 * (r >> 2)); MASK1(p1, r, (r & 3) + 8 * (r >> 2) + 32); } } \
        float pmax = fmaxf(fmaxf(p0[0], p0[1]), p1[0]); \
        _Pragma("unroll") for (int r = 2; r < 16; r += 2) pmax = fmaxf(fmaxf(pmax, p0[r]), p0[r + 1]); \
        _Pragma("unroll") for (int r = 1; r < 15; r += 2) pmax = fmaxf(fmaxf(pmax, p1[r]), p1[r + 1]); \
        pmax = fmaxf(pmax, p1[15]); \
        { auto rr = __builtin_amdgcn_permlane32_swap(__float_as_uint(pmax), __float_as_uint(pmax), false, false); pmax = fmaxf(__uint_as_float(rr[0]), __uint_as_float(rr[1])); } \
          \
          \
        if (!__all(pmax <= DEFER_THR)) { const float dl_ = fmaxf(pmax, 0.f); const float alpha = __builtin_amdgcn_exp2f(-dl_); m_reg += dl_; l_reg *= alpha; \
            _Pragma("unroll") for (int r = 0; r < 16; ++r) { p0[r] = fsub_s(p0[r], dl_); p1[r] = fsub_s(p1[r], dl_); } \
            _Pragma("unroll") for (int d_ = 0; d_ < 4; ++d_) _Pragma("unroll") for (int r = 0; r < 16; ++r) o[d_][r] = fmul_s(o[d_][r], alpha); } \
          \
          \
        float ps = 0.f; bf16x8 pa0, pa1, pa2, pa3; \
        s16x4 Al0, Al1, Al2, Al3, Ah0, Ah1, Ah2, Ah3, Bl0, Bl1, Bl2, Bl3, Bh0, Bh1, Bh2, Bh3; \
        SBAR(); asm volatile("s_waitcnt lgkmcnt(0)" ::: "memory");     \
        VLD(A, BUF, 0); SBAR(); \
        { unsigned a0, a1, b0, b1; EXS(p0, 0, 0, a0); EXS(p0, 0, 1, a1); EXS(p0, 0, 2, b0); EXS(p0, 0, 3, b1); PKQ(pa0); } SBAR(); \
        VLD(B, BUF, 1); LGK(8); \
        { unsigned a0, a1, b0, b1; QBODY(A, pa0, p0, 8); VLD(A, BUF, 2); SBAR(); QTAIL(p0, 8, pa1); } LGK(8); \
        { unsigned a0, a1, b0, b1; QBODY(B, pa1, p1, 0); VLD(B, BUF, 3); SBAR(); QTAIL(p1, 0, pa2); } LGK(8); \
        { unsigned a0, a1, b0, b1; QBODY(A, pa2, p1, 8); SBAR(); QTAIL(p1, 8, pa3); } \
        LGK(0); MM(B, 0, pa3); MM(B, 1, pa3); MM(B, 2, pa3); MM(B, 3, pa3); \
        { auto rr = __builtin_amdgcn_permlane32_swap(__float_as_uint(ps), __float_as_uint(ps), false, false); ps = __uint_as_float(rr[0]) + __uint_as_float(rr[1]); } \
        l_reg += ps; } SBAR(); \
        if (!grp) { if ((t_) + 2 < nrun) VMWAIT(NVP + NK_ + NVP); else if ((t_) + 1 < nrun) VMWAIT(NVP); else VMWAIT(0); }     \
        WGBAR(); } while (0)
#define PK4(P, B_, OUT) do { const unsigned a0 = cvtpk(P[B_ + 0], P[B_ + 1]), a1 = cvtpk(P[B_ + 2], P[B_ + 3]); \
        const unsigned b0 = cvtpk(P[B_ + 4], P[B_ + 5]), b1 = cvtpk(P[B_ + 6], P[B_ + 7]); \
        auto r0 = __builtin_amdgcn_permlane32_swap(a0, b0, false, false); auto r1 = __builtin_amdgcn_permlane32_swap(a1, b1, false, false); \
        u32x4 w = {r0[0], r1[0], r0[1], r1[1]}; OUT = *reinterpret_cast<bf16x8*>(&w); } while (0)
    for (int t = 0; t < nrun; t += 3) { STEP(0, t); if (t + 1 < nrun) STEP(1, t + 1); if (t + 2 < nrun) STEP(2, t + 2); }
    if (!grp) WGBAR();
#undef PK4
#undef STEP
#undef SCALE2
#undef KFR
#undef QTAIL
#undef QBODY
#undef ACC2
#undef EXP2
#undef PKQ
#undef EXS
#undef MM
#undef VLD
#undef LGK
#undef TRRD
#undef MASK1
#undef KT
#undef SCALE
#undef LOADV
#undef LOADK
#undef DMA16
#undef VMWAIT
#undef WGBAR
#undef QFRAG
    { const float rli = __builtin_amdgcn_rcpf(l_reg);
      int lane_e = lane; asm volatile("" : "+v"(lane_e));
      const int orow = B.orow0 + wid * 32 + (lane_e & 31), ocol = B.ocol0 + (lane_e >> 5) * 8;
#pragma unroll
      for (int d0 = 0; d0 < 4; ++d0)
#pragma unroll
          for (int g = 0; g < 4; g += 2) {
              unsigned ax = cvtpk(o[d0][4 * g] * rli, o[d0][4 * g + 1] * rli), ay = cvtpk(o[d0][4 * g + 2] * rli, o[d0][4 * g + 3] * rli);
              unsigned bx_ = cvtpk(o[d0][4 * g + 4] * rli, o[d0][4 * g + 5] * rli), by = cvtpk(o[d0][4 * g + 6] * rli, o[d0][4 * g + 7] * rli);
              { auto r = __builtin_amdgcn_permlane32_swap(ax, bx_, false, false); ax = r[0]; bx_ = r[1]; }
              { auto r = __builtin_amdgcn_permlane32_swap(ay, by, false, false); ay = r[0]; by = r[1]; }
              *(u32x4*)(B.O + act_off(orow, ocol + d0 * 32 + g * 8, T, DM)) = (u32x4){ax, ay, bx_, by}; } }
}

__device__ __forceinline__ void build_decay(char* lds, const float* lf, int n, const int wv) {
    int tid = tid_of(wv); asm volatile("" : "+v"(tid));
    const int wid = __builtin_amdgcn_readfirstlane(tid >> 6), lane = tid & 63;
    float* DL = (float*)(lds + l_dl(128)); float* scw = (float*)(lds + L_SC);
    float v[8]; const bool act = 8 * tid < n;
    { f32x4 a = act ? ld4(lf + 8 * tid) : (f32x4){0.f, 0.f, 0.f, 0.f}, b = act ? ld4(lf + 8 * tid + 4) : (f32x4){0.f, 0.f, 0.f, 0.f};
      v[0] = a[0]; v[1] = a[1]; v[2] = a[2]; v[3] = a[3]; v[4] = b[0]; v[5] = b[1]; v[6] = b[2]; v[7] = b[3]; }
#pragma unroll
    for (int e = 1; e < 8; ++e) v[e] += v[e - 1];
    const float tot = v[7]; float inc = tot;
#pragma unroll
    for (int o = 1; o < 64; o <<= 1) { const float y = __int_as_float(__builtin_amdgcn_ds_bpermute((lane - o) << 2, __float_as_int(inc))); if (lane >= o) inc += y; }
    if (lane == 63) scw[wid] = inc;
    __syncthreads();
    float base = inc - tot;
    for (int w = 0; w < wid; ++w) base += scw[w];
    if (act) {
#pragma unroll
        for (int e = 0; e < 8; ++e) DL[8 * tid + e] = -(base + v[e]) * LOG2E; }
}
}

constexpr size_t MiB = 1u << 20, KiB = 1u << 10;
constexpr size_t WS_CTL = 0, CTL_ZERO_BYTES = 1 * MiB;
constexpr size_t WS_RSTD0 = 1 * MiB;
constexpr size_t WS_RSTDM = WS_RSTD0 + 64 * KiB;
constexpr size_t WS_KRSS = WS_RSTDM + 64 * KiB;
constexpr size_t WS_MKSS = WS_KRSS + 128 * KiB;
constexpr size_t WS_CKVSS = WS_MKSS + 64 * KiB;
constexpr size_t WS_MQSS = WS_CKVSS + 512 * KiB;
constexpr size_t WS_CQSS = WS_MQSS + 1 * MiB;
constexpr size_t WS_LOGF = WS_CQSS + 1536 * KiB;
constexpr size_t WS_COS = WS_LOGF + 1536 * KiB;
constexpr size_t WS_SIN = WS_COS + 2 * MiB;
constexpr size_t WS_RSSA = WS_SIN + 2 * MiB;
constexpr size_t WS_RSSB = WS_RSSA + 4 * MiB;
constexpr size_t WS_KSS = WS_RSSB + 4 * MiB;
constexpr size_t WS_QSS = WS_KSS + 6 * MiB;
constexpr size_t WS_KSS1 = WS_QSS + 12 * MiB;
constexpr size_t WS_QSS1 = WS_KSS1 + 6 * MiB;
constexpr size_t WS_MQSS1 = WS_QSS1 + 12 * MiB;
constexpr size_t WS_SMALL_END = WS_MQSS1 + 1 * MiB;
static_assert(WS_SMALL_END <= 64 * MiB, "small arrays");
constexpr size_t WS_W_MEMKV = 64 * MiB;
constexpr size_t WS_W_FOXIN = WS_W_MEMKV + 16 * MiB;
constexpr size_t WS_W_O0 = WS_W_FOXIN + 82 * MiB, WS_W_O1 = WS_W_O0 + 32 * MiB;
constexpr size_t WS_W_UP0 = WS_W_O1 + 32 * MiB, WS_W_UP1 = WS_W_UP0 + 128 * MiB;
constexpr size_t WS_W_DN0 = WS_W_UP1 + 128 * MiB, WS_W_DN1 = WS_W_DN0 + 128 * MiB;
constexpr size_t WS_W_MLAIN = WS_W_DN1 + 128 * MiB;
constexpr size_t WS_W_QB = WS_W_MLAIN + 26 * MiB;
constexpr size_t WS_W_KVB = WS_W_QB + 14 * MiB;
constexpr size_t WS_XB = WS_W_KVB + 6 * MiB;
constexpr size_t WS_MEMN = WS_XB + 128 * MiB;
constexpr size_t WS_MK = WS_MEMN + 8 * MiB, WS_MV = WS_MK + 2 * MiB;
constexpr size_t WS_BIG = WS_MV + 2 * MiB;
constexpr size_t WS_HID = WS_BIG;
constexpr size_t WS_FQ = WS_BIG, WS_FK = WS_BIG + 96 * MiB, WS_FV = WS_BIG + 192 * MiB, WS_QM = WS_BIG + 288 * MiB, WS_MIX = WS_BIG + 320 * MiB;
constexpr size_t WS_CQ = WS_BIG, WS_CKV = WS_BIG + 48 * MiB, WS_RK = WS_BIG + 64 * MiB, WS_QM1 = WS_BIG + 68 * MiB, WS_QN = WS_BIG + 100 * MiB,
                 WS_QR = WS_BIG + 196 * MiB, WS_KN = WS_BIG + 244 * MiB, WS_VV = WS_BIG + 340 * MiB, WS_MIX1 = WS_BIG + 436 * MiB;
constexpr size_t WS_END = WS_BIG + 576 * MiB;
static_assert(WS_FV - WS_FK == WS_FK - WS_FQ, "Q | K | V equally spaced");
static_assert((size_t)FOXN * DM * 2 <= 82 * MiB && (size_t)MLAN * DM * 2 <= 26 * MiB && (size_t)QBN * QLR * 2 <= 14 * MiB, "weight slots");
constexpr int CW_BAR = 4096;

constexpr int RING_BYTES = 131072;
constexpr int L_TA = 135168, L_TB = 143360;
constexpr int MISC_OFF = 163328;
constexpr int LDS_BYTES = 163840;
constexpr int NWAVES = 8;
#ifndef ATT_MEM
#define ATT_MEM 1
#endif
#ifndef ATT_SELF
#define ATT_SELF 1
#endif
#ifndef PHASES
#define PHASES 0xFFF
#endif
#ifndef ATT_WRAP
#define ATT_WRAP 1
#endif
#ifndef REP_UP
#define REP_UP 1
#endif
#ifndef REP_WO
#define REP_WO 1
#endif
#ifndef REP_IN
#define REP_IN 1
#endif
#ifndef REP_DN
#define REP_DN 1
#endif
#ifndef W_BLK
#define W_BLK 1
#endif
#ifndef REP_P0
#define REP_P0 1
#endif
#ifndef REP_ATT
#define REP_ATT 1
#endif

#define XB_TMO      128
#define XB_XCNT(j)  (256  + 64 * (j))
#define XB_XSUB(j)  (1280 + 64 * (j))
#define XB_XGEN(j)  (2304 + 64 * (j))
#define XB_TOP      3328
#define XB_TOPGEN   3392
#define XCD_BAR_WORDS 3456
#define XB_SPIN_CAP (1u << 18)
__device__ __forceinline__ unsigned xb_ld(unsigned* p)              { return __hip_atomic_load(p, __ATOMIC_RELAXED, __HIP_MEMORY_SCOPE_AGENT); }
__device__ __forceinline__ unsigned xb_add(unsigned* p, unsigned v) { return __hip_atomic_fetch_add(p, v, __ATOMIC_RELAXED, __HIP_MEMORY_SCOPE_AGENT); }
__device__ __forceinline__ unsigned xb_xcc_id() { return (unsigned)__builtin_amdgcn_s_getreg((3 << 11) | 20) & 0xFu; }
#define XB_SPIN(cond, bar) do { unsigned _sp = 0; while (cond) { __builtin_amdgcn_s_sleep(1); \
    if ((++_sp & 255u) == 0u) { if (xb_ld(&(bar)[XB_TMO])) break; if (_sp > XB_SPIN_CAP) { atomicAdd(&(bar)[XB_TMO], 1u); break; } } } } while (0)
struct XcdBarrier { unsigned* bar; unsigned x; volatile LAS unsigned* st; };
__device__ __forceinline__ XcdBarrier xcd_barrier_post(unsigned* bar, volatile LAS unsigned* st) {
    XcdBarrier b; b.bar = bar; b.x = xb_xcc_id(); b.st = st;
    if (threadIdx.x == 0) (void)xb_add(&bar[XB_XCNT(b.x)], 1u);
    return b;
}
__device__ __forceinline__ void xcd_barrier_complete(unsigned* bar, unsigned x, unsigned& nloc, unsigned& nx) {
    const unsigned G = gridDim.x * gridDim.y * gridDim.z;
    unsigned sum, cnt, mine, sp = 0u;
    for (;;) {
        sum = 0u; cnt = 0u; mine = 0u;
#pragma unroll
        for (unsigned j = 0; j < 16; ++j) { const unsigned c = xb_ld(&bar[XB_XCNT(j)]); sum += c; cnt += (c > 0u) ? 1u : 0u; mine = (j == x) ? c : mine; }
        if (sum == G) break;
        __builtin_amdgcn_s_sleep(1);
        if ((++sp & 255u) == 0u) { if (xb_ld(&bar[XB_TMO])) break; if (sp > XB_SPIN_CAP) { atomicAdd(&bar[XB_TMO], 1u); break; } }
    }
    nloc = mine > 0u ? mine : 1u; nx = cnt > 0u ? cnt : 1u;
}
__device__ __forceinline__ void xcd_barrier(const XcdBarrier& b, const int wv) {
    asm volatile("s_waitcnt vmcnt(0)" ::: "memory");
    __syncthreads();
    if (wv == 0 && lane_id() == 0) {
        unsigned* bar = b.bar;
        __builtin_amdgcn_s_waitcnt(0);
        unsigned nloc = b.st[0], nx = b.st[1];
        if (nloc == 0u) { xcd_barrier_complete(bar, b.x, nloc, nx); b.st[0] = nloc; b.st[1] = nx; }
        const unsigned old = xb_add(&bar[XB_XSUB(b.x)], 1u);
        const unsigned gen = old / nloc;
        if (old + 1u == (gen + 1u) * nloc) {
            __builtin_amdgcn_fence(__ATOMIC_RELEASE, "agent");
            asm volatile("s_waitcnt vmcnt(0)" ::: "memory");
            const unsigned og = xb_add(&bar[XB_TOP], 1u);
            const unsigned tg = og / nx;
            if (og + 1u == (tg + 1u) * nx) xb_add(&bar[XB_TOPGEN], 1u);
            else XB_SPIN(xb_ld(&bar[XB_TOPGEN]) == tg, bar);
            __builtin_amdgcn_fence(__ATOMIC_ACQUIRE, "agent");
            xb_add(&bar[XB_XGEN(b.x)], 1u);
            asm volatile("s_waitcnt vmcnt(0)" ::: "memory");
        } else {
            XB_SPIN(xb_ld(&bar[XB_XGEN(b.x)]) == gen, bar);
            __builtin_amdgcn_fence(__ATOMIC_ACQUIRE, "agent");
            asm volatile("s_waitcnt vmcnt(0)" ::: "memory");
        }
    }
    __syncthreads();
}

#define LDS_WAIT() asm volatile("s_waitcnt lgkmcnt(0)" ::: "memory")
__device__ __forceinline__ float wave_sum(float v) {
#pragma unroll
    for (int o = 1; o < 64; o <<= 1) v += __shfl_xor(v, o);
    return v;
}
__device__ __forceinline__ int rope_rho(int s) { return 16 * (s >> 5) + 4 * ((s >> 3) & 3) + (s & 3) + 32 * ((s >> 2) & 1); }
__device__ __forceinline__ int src4(int kind, int n) {
    if (kind == 0) return n;
    if (kind == 1) return n < 9216 ? n : (n < 10240 ? n + 24 : (n < 10264 ? n - 1024 : -1));
    if (kind == 2) return n < 2048 ? n : (n < 3072 ? n + 64 : (n < 3136 ? 2048 + rope_rho(n - 3072) : -1));
    if (kind == 3) { if (n < 3072) return (n >> 7) * 192 + (n & 127); const int m = n - 3072; return (m >> 6) * 192 + 128 + rope_rho(m & 63); }
    { if (n < 3072) return (n >> 7) * 256 + (n & 127); const int m = n - 3072; return (m >> 7) * 256 + 128 + (m & 127); }
}
#define CONV_LOAD(V, it_) do { const int kb_ = (it_) / nblk, nb_ = (it_) - kb_ * nblk; const int sc_ = src4(kind, 32 * nb_ + 4 * g); \
        _Pragma("unroll") for (int i = 0; i < 8; ++i) { const int k_ = 64 * kb_ + 8 * i + kr; \
            V[i] = sc_ >= 0 ? ld4(W + (size_t)k_ * Nsrc + sc_) : (f32x4){0.f, 0.f, 0.f, 0.f}; } } while (0)
#define CONV_EMIT(V, it_) do { const int kb_ = (it_) / nblk, nb_ = (it_) - kb_ * nblk, k0_ = 64 * kb_, n0_ = 32 * nb_; \
        _Pragma("unroll") for (int i = 0; i < 8; ++i) { f32x4 v_ = V[i]; if (gf) v_ = v_ * gf[k0_ + 8 * i + kr]; \
            LAS float* s_ = scr + (8 * i + kr) * 33 + 4 * g; s_[0] = v_[0]; s_[1] = v_[1]; s_[2] = v_[2]; s_[3] = v_[3]; } \
        LDS_WAIT(); asm volatile("" ::: "memory"); \
        _Pragma("unroll") for (int j = 0; j < 4; ++j) { const int n_ = (lane >> 3) + 8 * j; const LAS float* s_ = scr + (8 * c) * 33 + n_; \
            u32x4 o_; o_.x = pg8::cvt_pk_bf16(s_[0 * 33], s_[1 * 33]); o_.y = pg8::cvt_pk_bf16(s_[2 * 33], s_[3 * 33]); o_.z = pg8::cvt_pk_bf16(s_[4 * 33], s_[5 * 33]); o_.w = pg8::cvt_pk_bf16(s_[6 * 33], s_[7 * 33]); \
            *(u32x4*)(WT + (blk ? ((size_t)kb_ * Ndst + (n0_ + n_)) * 64 + 8 * c : (size_t)(n0_ + n_) * K + k0_ + 8 * c)) = o_; } \
        LDS_WAIT(); asm volatile("" ::: "memory"); } while (0)
__device__ __forceinline__ void conv_matrix(const float* W, int K, int Nsrc, int Ndst, int kind, const float* gf, bf16* WT, LAS float* scr, int gw, int NGW, int lane, const int blk = 0) {
    const int nblk = Ndst / 32, nitems = (K / 64) * nblk;
    const int g = lane & 7, kr = lane >> 3, c = lane & 7;
    f32x4 va[8], vb[8];
    int it = gw; if (it >= nitems) return;
    CONV_LOAD(va, it);
    for (;;) {
        const int i1 = it + NGW; if (i1 < nitems) CONV_LOAD(vb, i1);
        CONV_EMIT(va, it);
        if (i1 >= nitems) break;
        const int i2 = i1 + NGW; if (i2 < nitems) CONV_LOAD(va, i2);
        CONV_EMIT(vb, i1);
        if (i2 >= nitems) break;
        it = i2;
    }
}
__device__ __forceinline__ void conv_matrix4(const float* W, int K, int Nsrc, int Ndst, int kind, const float* gf, bf16* WT, LAS float* scr, int gw, int NGW, int lane, const int blk = 0) {
    const int nblk = Ndst / 32, nitems = (K / 64) * nblk;
    const int g = lane & 7, kr = lane >> 3, c = lane & 7;
    f32x4 va[8], vb[8], vc[8], vd[8];
    int i0 = gw; if (i0 >= nitems) return;
    int i1 = i0 + NGW, i2 = i1 + NGW, i3 = i2 + NGW;
    CONV_LOAD(va, i0); if (i1 < nitems) CONV_LOAD(vb, i1); if (i2 < nitems) CONV_LOAD(vc, i2);
    for (;;) {
        if (i3 < nitems) CONV_LOAD(vd, i3);
        CONV_EMIT(va, i0); if (i1 >= nitems) break;
        const int i4 = i3 + NGW; if (i4 < nitems) CONV_LOAD(va, i4);
        CONV_EMIT(vb, i1); if (i2 >= nitems) break;
        const int i5 = i4 + NGW; if (i5 < nitems) CONV_LOAD(vb, i5);
        CONV_EMIT(vc, i2); if (i3 >= nitems) break;
        const int i6 = i5 + NGW; if (i6 < nitems) CONV_LOAD(vc, i6);
        CONV_EMIT(vd, i3); if (i4 >= nitems) break;
        i0 = i4; i1 = i5; i2 = i6; i3 = i6 + NGW;
    }
}
#undef CONV_LOAD
#undef CONV_EMIT
__device__ __forceinline__ void row_to_bf16_rstd(const float* xrow, bf16* obase, int m, int M, float* rstd, int lane) {
    const f32x4* xr = (const f32x4*)xrow + lane; float s = 0.f; f32x4 v[16];
#pragma unroll
    for (int j = 0; j < 16; ++j) { v[j] = xr[64 * j]; s += ss4(v[j]); }
    s = wave_sum(s);
    if (lane == 0) *rstd = rsqrtf(s * (1.f / DM) + EPS);
#pragma unroll
    for (int j = 0; j < 16; ++j) { u32x2 w; w.x = pg8::cvt_pk_bf16(v[j][0], v[j][1]); w.y = pg8::cvt_pk_bf16(v[j][2], v[j][3]); *(u32x2*)(obase + act_off(m, 256 * j + 4 * lane, M, DM)) = w; }
}
__device__ __forceinline__ void build_rtab(LAS float* tab, const float* src, int np, int rbase, int nrows, float inv_dim, const int wv) {
    int t0 = tid_of(wv); asm volatile("" : "+v"(t0));
    for (int r = t0; r < nrows; r += NWAVES * 64) {
        if (np == 0) { tab[r] = src[rbase + r]; continue; }
        const float* p = src + (size_t)(rbase + r) * np; float s = 0.f;
        for (int i = 0; i < np; i += 4) { const f32x4 v = ld4(p + i); s += (v[0] + v[1]) + (v[2] + v[3]); }
        tab[r] = rsqrtf(s * inv_dim + EPS);
    }
}

struct Args {
    const float *x, *mem; const int* pos; const float *mem_norm_g, *w_mem_kv, *mem_k_norm_g, *attn_norm_g, *memq_norm_g, *w_o, *mlp_norm_g, *w_up, *w_down,
        *fox_w_in, *fox_b_f, *fox_q_norm_g, *fox_k_norm_g, *mla_w_in, *mla_q_a_norm_g, *mla_w_q_b, *mla_kv_a_norm_g, *mla_w_kv_b, *mla_q_norm_g, *mla_k_norm_g;
    float* out; unsigned char* ws;
};
struct ArgsG {
    const GAS float *x, *mem; const GAS int* pos; const GAS float *mem_norm_g, *w_mem_kv, *mem_k_norm_g, *attn_norm_g, *memq_norm_g, *w_o, *mlp_norm_g, *w_up, *w_down,
        *fox_w_in, *fox_b_f, *fox_q_norm_g, *fox_k_norm_g, *mla_w_in, *mla_q_a_norm_g, *mla_w_q_b, *mla_kv_a_norm_g, *mla_w_kv_b, *mla_q_norm_g, *mla_k_norm_g;
    GAS float* out; GAS unsigned char* ws;
};
static_assert(sizeof(ArgsG) == sizeof(Args) && sizeof(Args) == 25 * 8, "argument block");
__device__ __forceinline__ Args to_generic(const ArgsG& g) {
    Args a;
    a.x = (const float*)g.x; a.mem = (const float*)g.mem; a.pos = (const int*)g.pos; a.mem_norm_g = (const float*)g.mem_norm_g; a.w_mem_kv = (const float*)g.w_mem_kv;
    a.mem_k_norm_g = (const float*)g.mem_k_norm_g; a.attn_norm_g = (const float*)g.attn_norm_g; a.memq_norm_g = (const float*)g.memq_norm_g; a.w_o = (const float*)g.w_o;
    a.mlp_norm_g = (const float*)g.mlp_norm_g; a.w_up = (const float*)g.w_up; a.w_down = (const float*)g.w_down; a.fox_w_in = (const float*)g.fox_w_in; a.fox_b_f = (const float*)g.fox_b_f;
    a.fox_q_norm_g = (const float*)g.fox_q_norm_g; a.fox_k_norm_g = (const float*)g.fox_k_norm_g; a.mla_w_in = (const float*)g.mla_w_in; a.mla_q_a_norm_g = (const float*)g.mla_q_a_norm_g;
    a.mla_w_q_b = (const float*)g.mla_w_q_b; a.mla_kv_a_norm_g = (const float*)g.mla_kv_a_norm_g; a.mla_w_kv_b = (const float*)g.mla_w_kv_b; a.mla_q_norm_g = (const float*)g.mla_q_norm_g;
    a.mla_k_norm_g = (const float*)g.mla_k_norm_g; a.out = (float*)g.out; a.ws = (unsigned char*)g.ws;
    return a;
}

__global__ void __launch_bounds__(NWAVES * 64, 2) mk_fwd(ArgsG a_in) {
    extern __shared__ __attribute__((aligned(16))) unsigned char lds[];
    LAS unsigned char* L = (LAS unsigned char*)lds;
    const int tid0 = threadIdx.x, wave = __builtin_amdgcn_readfirstlane(tid0 >> 6);
    const int G = gridDim.x, bx = blockIdx.x;
    unsigned char* ws0 = (unsigned char*)a_in.ws;
    volatile LAS unsigned* MISC = (volatile LAS unsigned*)(L + MISC_OFF);
    if (tid0 < 64) MISC[tid0] = 0u;
    __syncthreads();
    XcdBarrier bar = xcd_barrier_post((unsigned*)(ws0 + WS_CTL) + CW_BAR, MISC + 8);
    const int rbase = 2048 * (bx & 7);
    LAS float* TA = (LAS float*)(L + L_TA); LAS float* TB = (LAS float*)(L + L_TB);
#if defined(__HIP_DEVICE_COMPILE__)
#define LOAD_ARGS(a, ap) const ArgsG ag_ = *(ap); const Args a = to_generic(ag_)
#else
#define LOAD_ARGS(a, ap) const Args a = to_generic(a_in)
#endif
#define PHASE_VARS const __attribute__((address_space(4))) ArgsG* ap_ = (const __attribute__((address_space(4))) ArgsG*)__builtin_amdgcn_kernarg_segment_ptr(); asm volatile("" : "+s"(ap_)); LOAD_ARGS(a, ap_); \
    GAS unsigned char* wsg_ = (GAS unsigned char*)a.ws; asm volatile("" : "+s"(wsg_)); unsigned char* ws = (unsigned char*)wsg_; int tid = tid_of(wave); asm volatile("" : "+v"(tid)); (void)tid; const int lane = tid & 63; (void)lane; \
    bf16* XB = (bf16*)(ws + WS_XB); float* RSSA = (float*)(ws + WS_RSSA); float* RSSB = (float*)(ws + WS_RSSB); float* COS = (float*)(ws + WS_COS); float* SIN = (float*)(ws + WS_SIN); \
    float* MQSS = (float*)(ws + WS_MQSS); float* QSS = (float*)(ws + WS_QSS); float* KSS = (float*)(ws + WS_KSS); \
    float* MQSS1 = (float*)(ws + WS_MQSS1); float* QSS1 = (float*)(ws + WS_QSS1); float* KSS1 = (float*)(ws + WS_KSS1); (void)MQSS1; (void)QSS1; (void)KSS1; \
    (void)XB; (void)RSSA; (void)RSSB; (void)COS; (void)SIN; (void)MQSS; (void)QSS; (void)KSS;

    if constexpr ((PHASES >> 0) & 1)
    for (int rep_ = 0; rep_ < REP_P0; ++rep_)
    { PHASE_VARS
        const int vcu = (G % 8 == 0) ? (bx % 8) * (G / 8) + bx / 8 : bx;
        const int gw = vcu * NWAVES + wave, NGW = G * NWAVES;
        LAS float* scr = (LAS float*)(L + wave * 16384);
        conv_matrix(a.fox_w_in, DM, FOX_SRC, FOXN, 1, a.attn_norm_g, (bf16*)(ws + WS_W_FOXIN), scr, gw, NGW, lane, W_BLK);
        if (G != 256) conv_matrix(a.w_o + (size_t)DM * DM, DM, DM, DM, 0, nullptr, (bf16*)(ws + WS_W_O1), scr, gw, NGW, lane, W_BLK);
        conv_matrix(a.w_mem_kv, DM, 2048, 2048, 0, a.mem_norm_g, (bf16*)(ws + WS_W_MEMKV), scr, gw, NGW, lane, W_BLK);
        for (int m = gw; m < T; m += NGW) row_to_bf16_rstd(a.x + (size_t)m * DM, XB, m, T, (float*)(ws + WS_RSTD0) + m, lane);
        for (int m = gw; m < MT; m += NGW) row_to_bf16_rstd(a.mem + (size_t)m * DM, (bf16*)(ws + WS_MEMN), m, MT, (float*)(ws + WS_RSTDM) + m, lane);
        for (int idx = (vcu * NWAVES * 64) + tid; idx < T * 32; idx += G * NWAVES * 64) {
            const int tok = idx >> 5, i = idx & 31;
            const float invf = 1.0f / powf(10000.0f, (float)(2 * i) * (1.0f / 64.0f));
            const float ang = (float)a.pos[tok] * invf; float sn, cs; sincosf(ang, &sn, &cs);
            COS[idx] = cs; SIN[idx] = sn;
        }
    }
    xcd_barrier(bar, wave);

    if constexpr ((PHASES >> 1) & 1)
    for (int rep_ = 0; rep_ < REP_IN; ++rep_)
    { PHASE_VARS if (rep_) __syncthreads();
        build_rtab(TA, (const float*)(ws + WS_RSTD0), 0, rbase, 2048, 0.f, wave);
        build_rtab(TB, (const float*)(ws + WS_RSTDM), 0, 0, MT, 0.f, wave);
        __syncthreads();
        { pg8::Gemm g{(const bf16*)(ws + WS_MEMN), (const bf16*)(ws + WS_W_MEMKV), MT, 2048, DM, W_BLK, A_BLK}; pg8::StaticOrder S; S.init(MT, 2048, G, (bx >= 64 && bx < 96) ? bx - 64 : (1 << 20));
          EpiMemKV E{(bf16*)(ws + WS_MK), (bf16*)(ws + WS_MV), (float*)(ws + WS_MKSS), TB, 0};
          pg8::gemm_phase<EpiMemKV, pg8::StaticOrder, true, true>(L, g, S, E, wave); }
        { pg8::Gemm g{XB, (const bf16*)(ws + WS_W_FOXIN), T, FOXN, DM, W_BLK, A_BLK}; pg8::StaticOrder S; S.init(T, FOXN, G, bx);
          EpiFoxIn E{(bf16*)(ws + WS_FQ), (bf16*)(ws + WS_QM), (WS_FK - WS_FQ) / 2, QSS, KSS, MQSS, (float*)(ws + WS_LOGF),
                     a.fox_q_norm_g, a.fox_k_norm_g, a.memq_norm_g, a.mem_k_norm_g, a.fox_b_f, TA, rbase};
          pg8::gemm_phase<EpiFoxIn, pg8::StaticOrder, true, true>(L, g, S, E, wave); }
        if (G == 256 && bx >= 96) conv_matrix4(a.w_up + (size_t)DM * FF, DM, FF, FF, 0, a.mlp_norm_g + DM, (bf16*)(ws + WS_W_UP1), (LAS float*)(L + wave * 16384), (bx - 96) * NWAVES + wave, 160 * NWAVES, lane, W_BLK);
        else if (G != 256) conv_matrix(a.w_up + (size_t)DM * FF, DM, FF, FF, 0, a.mlp_norm_g + DM, (bf16*)(ws + WS_W_UP1), (LAS float*)(L + wave * 16384), bx * NWAVES + wave, G * NWAVES, lane, W_BLK);
    }
    xcd_barrier(bar, wave);

    if constexpr ((PHASES >> 2) & 1)
    for (int rep_ = 0; rep_ < REP_ATT; ++rep_)
    { PHASE_VARS if (rep_) __syncthreads();
        char* al = (char*)lds;
#define P2_CONV() do { const int vcu = (G % 8 == 0) ? (bx % 8) * (G / 8) + bx / 8 : bx; const int gw = vcu * NWAVES + wave, NGW = G * NWAVES; LAS float* scr = (LAS float*)(L + wave * 16384); \
            __syncthreads(); \
            conv_matrix(a.w_o, DM, DM, DM, 0, nullptr, (bf16*)(ws + WS_W_O0), scr, gw, NGW, lane, W_BLK); \
            conv_matrix(a.w_up, DM, FF, FF, 0, a.mlp_norm_g, (bf16*)(ws + WS_W_UP0), scr, gw, NGW, lane, W_BLK); \
            conv_matrix(a.w_down, FF, DM, DM, 0, nullptr, (bf16*)(ws + WS_W_DN0), scr, gw, NGW, lane, W_BLK); \
            conv_matrix(a.mla_w_in, DM, MLA_SRC, MLAN, 2, a.attn_norm_g + DM, (bf16*)(ws + WS_W_MLAIN), scr, gw, NGW, lane, W_BLK); \
            conv_matrix(a.mla_w_q_b, QLR, QBN, QBN, 3, a.mla_q_a_norm_g, (bf16*)(ws + WS_W_QB), scr, gw, NGW, lane, W_BLK); \
            conv_matrix(a.mla_w_kv_b, KVLR, KVBN, KVBN, 4, a.mla_kv_a_norm_g, (bf16*)(ws + WS_W_KVB), scr, gw, NGW, lane, W_BLK); \
            __syncthreads(); } while (0)
        if (rep_ == 0 && (bx & 1)) P2_CONV();
        asm volatile("" ::: "memory");
        float skip_th;
        { float gm = 0.f; for (int d = 0; d < 128; d += 4) { const f32x4 g4 = ld4(a.fox_q_norm_g + d) * ld4(a.fox_k_norm_g + d); gm = fmaxf(fmaxf(gm, fmaxf(fabsf(g4[0]), fabsf(g4[1]))), fmaxf(fabsf(g4[2]), fabsf(g4[3]))); }
          skip_th = 34.f * gm + 136.f + 8.f; }
        if constexpr (ATT_SELF) for (int i = 0;; ++i) {
            int Lid = i * G + bx; if (Lid >= 768 * ATT_WRAP) break; Lid = Lid >= 768 ? Lid - 768 : Lid;
            const int xcd = Lid & 7, k = Lid >> 3, bh = xcd * 12 + (k >> 3), x = ((k & 7) + 3 * (k >> 5)) & 7, b = bh / NH, h = bh - b * NH;
            const int nkeys = 256 * (16 - x);
            att::build_decay(al, (const float*)(ws + WS_LOGF) + (size_t)bh * SEQ, nkeys, wave);
            { int tl = tid_of(wave); asm volatile("" : "+v"(tl)); float* RKt = (float*)(al + att::l_rk(128)); const float* kp = KSS + ((size_t)b * SEQ * NH + h) * 4;
              for (int s = tl; s < nkeys; s += NWAVES * 64) { const f32x4 p = ld4(kp + (size_t)s * NH * 4); RKt[s] = rsqrtf(((p[0] + p[1]) + (p[2] + p[3])) * (1.f / 128.f) + EPS) * (0.08838834764831845f * LOG2E); } }
            __syncthreads();
            for (int pass = 0; pass < 2; ++pass) {
                const int qb = pass ? 15 - x : x; const size_t r0 = (size_t)b * SEQ + qb * 256;
                att::Blk B;
                B.Qa = (const bf16*)(ws + WS_FQ) + ((size_t)h * T + r0) * 128; B.Qb = B.Qa;
                B.Ka = (const bf16*)(ws + WS_FK) + ((size_t)h * T + (size_t)b * SEQ) * 128; B.Kb = B.Ka;
                B.V = (const bf16*)(ws + WS_FV) + ((size_t)h * T + (size_t)b * SEQ) * 128;
                B.O = (bf16*)(ws + WS_MIX); B.orow0 = (int)r0; B.ocol0 = h * 128;
                B.qssp = QSS + (r0 * NH + h) * 4;
                B.nkt = 4 * (qb + 1); B.qpos0 = qb * 256;
                { const float* NDLt = (const float*)(al + att::l_dl(128)); const int kt_ = lane_id(); const float ref_ = NDLt[qb * 256];
                  const bool need_ = kt_ < B.nkt && !(ref_ - NDLt[64 * kt_ + 63] > skip_th);
                  const unsigned long long mk_ = __ballot(need_); const int ktmin_ = mk_ ? (int)__builtin_ctzll(mk_) : 0;
                  B.nrun = B.nkt - __builtin_amdgcn_readfirstlane(ktmin_); }
                att::attn_block<128, 128, 4, true, true, true, true, att::Pitch<128, 128, 128, 128, 128, NH * 4>>(al, B, wave);
            }
        }
        if (rep_ == 0 && !(bx & 1)) P2_CONV();
#undef P2_CONV
        if constexpr (ATT_MEM) for (int u_ = bx; u_ < NB * NMH * 16 * ATT_WRAP; u_ += G) { const int u = u_ & 255;
            const int b = u >> 6, mh = (u >> 4) & 3, qb = u & 15; const size_t r0 = (size_t)b * SEQ + qb * 256;
            __syncthreads();
            { int tl = tid_of(wave); asm volatile("" : "+v"(tl)); float* RKt = (float*)(al + att::l_rk(256)); const float* kp = (const float*)(ws + WS_MKSS) + ((size_t)mh * MT + (size_t)b * MLEN) * 4;
              for (int s = tl; s < MLEN; s += NWAVES * 64) { const f32x4 p = ld4(kp + (size_t)s * 4); RKt[s] = rsqrtf(((p[0] + p[1]) + (p[2] + p[3])) * (1.f / 256.f) + EPS) * (0.0625f * LOG2E); } }
            __syncthreads();
            for (int pass = 0; pass < 2; ++pass) {
                att::Blk B;
                B.Qa = (const bf16*)(ws + WS_QM) + ((size_t)mh * T + r0) * 256; B.Qb = B.Qa;
                B.Ka = (const bf16*)(ws + WS_MK) + (size_t)b * MLEN * 1024 + mh * 256; B.Kb = B.Ka;
                B.V = (const bf16*)(ws + WS_MV) + (size_t)b * MLEN * 1024 + mh * 256 + pass * 128;
                B.O = (bf16*)(ws + WS_MIX); B.orow0 = (int)r0; B.ocol0 = 3072 + mh * 256 + pass * 128;
                B.qssp = MQSS + (r0 * NMH + mh) * 4;
                B.nkt = 4; B.nrun = 4; B.qpos0 = 0;
                att::attn_block<256, 256, 4, false, false, false, false, att::Pitch<256, 256, 1024, 1024, 1024, NMH * 4>>(al, B, wave);
            }
        }
    }
    xcd_barrier(bar, wave);

    if constexpr ((PHASES >> 3) & 1)
    for (int rep_ = 0; rep_ < REP_WO; ++rep_)
    { constexpr int REP_X = REP_WO; PHASE_VARS if (rep_) __syncthreads(); pg8::Gemm g{(const bf16*)(ws + WS_MIX), (const bf16*)(ws + WS_W_O0), T, DM, DM, W_BLK, A_BLK}; pg8::StaticOrder S; S.init(T, DM, G, bx);
      EpiRes<false> E{XB, (rep_ + 1 < REP_X) ? (bf16*)(ws + WS_END) : XB, nullptr, RSSA};
      pg8::gemm_phase<EpiRes<false>, pg8::StaticOrder, true, true>(L, g, S, E, wave); }
    xcd_barrier(bar, wave);

    if constexpr ((PHASES >> 4) & 1)
    for (int rep_ = 0; rep_ < REP_UP; ++rep_)
    { PHASE_VARS if (rep_) __syncthreads(); build_rtab(TA, RSSA, 64, rbase, 2048, 1.f / DM, wave); __syncthreads();
      pg8::Gemm g{XB, (const bf16*)(ws + WS_W_UP0), T, FF, DM, W_BLK, A_BLK}; pg8::StaticOrder S; S.init(T, FF, G, bx);
      EpiUp E{(bf16*)(ws + WS_HID), TA, rbase};
      pg8::gemm_phase<EpiUp, pg8::StaticOrder, true, true>(L, g, S, E, wave); }
    xcd_barrier(bar, wave);

    if constexpr ((PHASES >> 5) & 1)
    for (int rep_ = 0; rep_ < REP_DN; ++rep_)
    { constexpr int REP_X = REP_DN; PHASE_VARS if (rep_) __syncthreads(); pg8::Gemm g{(const bf16*)(ws + WS_HID), (const bf16*)(ws + WS_W_DN0), T, DM, FF, W_BLK, HID_BLK}; pg8::StaticOrder S; S.init(T, DM, G, bx);
      EpiRes<false> E{XB, (rep_ + 1 < REP_X) ? (bf16*)(ws + WS_END) : XB, nullptr, RSSB};
      pg8::gemm_phase<EpiRes<false>, pg8::StaticOrder, true, true>(L, g, S, E, wave); }
    xcd_barrier(bar, wave);

    if constexpr ((PHASES >> 6) & 1)
    for (int rep_ = 0; rep_ < REP_IN; ++rep_)
    { PHASE_VARS if (rep_) __syncthreads(); build_rtab(TA, RSSB, 64, rbase, 2048, 1.f / DM, wave); __syncthreads();
      pg8::Gemm g{XB, (const bf16*)(ws + WS_W_MLAIN), T, MLAN, DM, W_BLK, A_BLK}; pg8::StaticOrder S; S.init(T, MLAN, G, bx);
      EpiMlaIn E{(bf16*)(ws + WS_CQ), (bf16*)(ws + WS_CKV), (bf16*)(ws + WS_QM1), (bf16*)(ws + WS_RK), (float*)(ws + WS_CQSS), (float*)(ws + WS_CKVSS), MQSS1, (float*)(ws + WS_KRSS),
                 a.memq_norm_g + 256, a.mem_k_norm_g, a.mla_k_norm_g, COS, SIN, TA, rbase};
      pg8::gemm_phase<EpiMlaIn, pg8::StaticOrder, true, true>(L, g, S, E, wave);
      if (G == 256 && bx >= 64) conv_matrix4(a.w_down + (size_t)FF * DM, FF, DM, DM, 0, nullptr, (bf16*)(ws + WS_W_DN1), (LAS float*)(L + wave * 16384), (bx - 64) * NWAVES + wave, 192 * NWAVES, lane, W_BLK);
      else if (G != 256) conv_matrix(a.w_down + (size_t)FF * DM, FF, DM, DM, 0, nullptr, (bf16*)(ws + WS_W_DN1), (LAS float*)(L + wave * 16384), bx * NWAVES + wave, G * NWAVES, lane, W_BLK); }
    xcd_barrier(bar, wave);

    if constexpr ((PHASES >> 7) & 1)
    for (int rep_ = 0; rep_ < REP_IN; ++rep_)
    { PHASE_VARS if (rep_) __syncthreads(); build_rtab(TA, (const float*)(ws + WS_CQSS), 24, rbase, 2048, 1.f / QLR, wave); build_rtab(TB, (const float*)(ws + WS_CKVSS), 8, rbase, 2048, 1.f / KVLR, wave); __syncthreads();
      { pg8::Gemm g{(const bf16*)(ws + WS_CQ), (const bf16*)(ws + WS_W_QB), T, QBN, QLR, W_BLK, A_BLK}; pg8::StaticOrder S; S.init(T, QBN, G, bx);
        EpiQB E{(bf16*)(ws + WS_QN), (bf16*)(ws + WS_QR), QSS1, a.mla_q_norm_g, a.mla_k_norm_g, COS, SIN, TA, rbase};
        pg8::gemm_phase<EpiQB, pg8::StaticOrder, true, true>(L, g, S, E, wave); }
      { pg8::Gemm g{(const bf16*)(ws + WS_CKV), (const bf16*)(ws + WS_W_KVB), T, KVBN, KVLR, W_BLK, A_BLK}; pg8::StaticOrder S; S.init(T, KVBN, G, (bx + 128) % G);
        EpiKVB E{(bf16*)(ws + WS_KN), (bf16*)(ws + WS_VV), KSS1, TB, rbase};
        pg8::gemm_phase<EpiKVB, pg8::StaticOrder, true, true>(L, g, S, E, wave); }
      if (G == 256 && bx >= 128) conv_matrix4(a.w_o + (size_t)DM * DM, DM, DM, DM, 0, nullptr, (bf16*)(ws + WS_W_O1), (LAS float*)(L + wave * 16384), (bx - 128) * NWAVES + wave, 128 * NWAVES, lane, W_BLK);
}
    xcd_barrier(bar, wave);

    if constexpr ((PHASES >> 8) & 1)
    for (int rep_ = 0; rep_ < REP_ATT; ++rep_)
    { PHASE_VARS if (rep_) __syncthreads();
        char* al = (char*)lds;
        if constexpr (ATT_SELF) for (int i = 0;; ++i) {
            int Lid = i * G + bx; if (Lid >= 768 * ATT_WRAP) break; Lid = Lid >= 768 ? Lid - 768 : Lid;
            const int xcd = Lid & 7, k = Lid >> 3, bh = xcd * 12 + (k >> 3), x = k & 7, b = bh / NH, h = bh - b * NH;
            const int nkeys = 256 * (16 - x);
            __syncthreads();
            { int tl = tid_of(wave); asm volatile("" : "+v"(tl)); float* RKt = (float*)(al + att::l_rk(192)); const float* kp = KSS1 + ((size_t)b * SEQ * NH + h) * 4; const float* rp = (const float*)(ws + WS_KRSS) + (size_t)b * SEQ * 2;
              for (int s = tl; s < nkeys; s += NWAVES * 64) { const f32x4 p = ld4(kp + (size_t)s * NH * 4); const f32x2 q = *(const f32x2*)(rp + (size_t)s * 2);
                  RKt[s] = rsqrtf((((p[0] + p[1]) + (p[2] + p[3])) + (q[0] + q[1])) * (1.f / 192.f) + EPS) * (0.07216878364870323f * LOG2E); } }
            __syncthreads();
            for (int pass = 0; pass < 2; ++pass) {
                const int qb = pass ? 15 - x : x; const size_t r0 = (size_t)b * SEQ + qb * 256;
                att::Blk B;
                B.Qa = (const bf16*)(ws + WS_QN) + ((size_t)h * T + r0) * 128; B.Qb = (const bf16*)(ws + WS_QR) + ((size_t)h * T + r0) * 64;
                B.Ka = (const bf16*)(ws + WS_KN) + ((size_t)h * T + (size_t)b * SEQ) * 128; B.Kb = (const bf16*)(ws + WS_RK) + (size_t)b * SEQ * 64;
                B.V = (const bf16*)(ws + WS_VV) + ((size_t)h * T + (size_t)b * SEQ) * 128;
                B.O = (bf16*)(ws + WS_MIX1); B.orow0 = (int)r0; B.ocol0 = h * 128;
                B.qssp = QSS1 + (r0 * NH + h) * 8;
                B.nkt = 4 * (qb + 1); B.nrun = B.nkt; B.qpos0 = qb * 256;
                att::attn_block<192, 128, 6, true, false, true, false, att::Pitch<128, 64, 128, 64, 128, NH * 8>>(al, B, wave);
            }
        }
        if constexpr (ATT_MEM) for (int u_ = bx; u_ < NB * NMH * 16 * ATT_WRAP; u_ += G) { const int u = u_ & 255;
            const int b = u >> 6, mh = (u >> 4) & 3, qb = u & 15; const size_t r0 = (size_t)b * SEQ + qb * 256;
            __syncthreads();
            { int tl = tid_of(wave); asm volatile("" : "+v"(tl)); float* RKt = (float*)(al + att::l_rk(256)); const float* kp = (const float*)(ws + WS_MKSS) + ((size_t)mh * MT + (size_t)b * MLEN) * 4;
              for (int s = tl; s < MLEN; s += NWAVES * 64) { const f32x4 p = ld4(kp + (size_t)s * 4); RKt[s] = rsqrtf(((p[0] + p[1]) + (p[2] + p[3])) * (1.f / 256.f) + EPS) * (0.0625f * LOG2E); } }
            __syncthreads();
            for (int pass = 0; pass < 2; ++pass) {
                att::Blk B;
                B.Qa = (const bf16*)(ws + WS_QM1) + ((size_t)mh * T + r0) * 256; B.Qb = B.Qa;
                B.Ka = (const bf16*)(ws + WS_MK) + (size_t)b * MLEN * 1024 + mh * 256; B.Kb = B.Ka;
                B.V = (const bf16*)(ws + WS_MV) + (size_t)b * MLEN * 1024 + mh * 256 + pass * 128;
                B.O = (bf16*)(ws + WS_MIX1); B.orow0 = (int)r0; B.ocol0 = 3072 + mh * 256 + pass * 128;
                B.qssp = MQSS1 + (r0 * NMH + mh) * 4;
                B.nkt = 4; B.nrun = 4; B.qpos0 = 0;
                att::attn_block<256, 256, 4, false, false, false, false, att::Pitch<256, 256, 1024, 1024, 1024, NMH * 4>>(al, B, wave);
            }
        }
    }
    xcd_barrier(bar, wave);

    if constexpr ((PHASES >> 9) & 1)
    for (int rep_ = 0; rep_ < REP_WO; ++rep_)
    { constexpr int REP_X = REP_WO; PHASE_VARS if (rep_) __syncthreads(); pg8::Gemm g{(const bf16*)(ws + WS_MIX1), (const bf16*)(ws + WS_W_O1), T, DM, DM, W_BLK, A_BLK}; pg8::StaticOrder S; S.init(T, DM, G, bx);
      EpiRes<false> E{XB, (rep_ + 1 < REP_X) ? (bf16*)(ws + WS_END) : XB, nullptr, RSSA};
      pg8::gemm_phase<EpiRes<false>, pg8::StaticOrder, true, true>(L, g, S, E, wave); }
    xcd_barrier(bar, wave);

    if constexpr ((PHASES >> 10) & 1)
    for (int rep_ = 0; rep_ < REP_UP; ++rep_)
    { PHASE_VARS if (rep_) __syncthreads(); build_rtab(TA, RSSA, 64, rbase, 2048, 1.f / DM, wave); __syncthreads();
      pg8::Gemm g{XB, (const bf16*)(ws + WS_W_UP1), T, FF, DM, W_BLK, A_BLK}; pg8::StaticOrder S; S.init(T, FF, G, bx);
      EpiUp E{(bf16*)(ws + WS_HID), TA, rbase};
      pg8::gemm_phase<EpiUp, pg8::StaticOrder, true, true>(L, g, S, E, wave); }
    xcd_barrier(bar, wave);

    if constexpr ((PHASES >> 11) & 1)
    { PHASE_VARS pg8::Gemm g{(const bf16*)(ws + WS_HID), (const bf16*)(ws + WS_W_DN1), T, DM, FF, W_BLK, HID_BLK}; pg8::StaticOrder S; S.init(T, DM, G, bx);
      EpiRes<true> E{XB, XB, a.out, nullptr};
      pg8::gemm_phase<EpiRes<true>, pg8::StaticOrder, true, true>(L, g, S, E, wave); }
}

extern "C" void kernel_launch(void* const* d_in, const int* in_sizes, int n_in, void* d_out, int out_size, void* d_ws, size_t ws_size, hipStream_t stream) {
    static int grid = 0;
    if (grid == 0) {
        if (n_in != 23 || ws_size < WS_END) { fprintf(stderr, "kernel_launch: need 23 inputs and >= %zu bytes of workspace; got %d, %zu\n", (size_t)WS_END, n_in, ws_size); grid = -1; return; }
        int dev = 0, cus = 0, per_cu = 0;
        if (hipGetDevice(&dev) != hipSuccess || hipDeviceGetAttribute(&cus, hipDeviceAttributeMultiprocessorCount, dev) != hipSuccess) { grid = -1; return; }
        if (hipFuncSetAttribute((const void*)mk_fwd, hipFuncAttributeMaxDynamicSharedMemorySize, LDS_BYTES) != hipSuccess) { fprintf(stderr, "kernel_launch: hipFuncSetAttribute failed\n"); grid = -1; return; }
        if (hipOccupancyMaxActiveBlocksPerMultiprocessor(&per_cu, (const void*)mk_fwd, NWAVES * 64, LDS_BYTES) != hipSuccess || per_cu < 1) { fprintf(stderr, "kernel_launch: occupancy query says %d\n", per_cu); }
        (void)hipGetLastError();
        grid = cus;
        if (grid % 8 != 0) grid -= grid % 8;
    }
    if (grid <= 0) return;
    (void)hipMemsetAsync((char*)d_ws + WS_CTL, 0, CTL_ZERO_BYTES, stream);
    Args a{};
    a.x = (const float*)d_in[0]; a.mem = (const float*)d_in[1]; a.pos = (const int*)d_in[2]; a.mem_norm_g = (const float*)d_in[3]; a.w_mem_kv = (const float*)d_in[4];
    a.mem_k_norm_g = (const float*)d_in[5]; a.attn_norm_g = (const float*)d_in[6]; a.memq_norm_g = (const float*)d_in[7]; a.w_o = (const float*)d_in[8];
    a.mlp_norm_g = (const float*)d_in[9]; a.w_up = (const float*)d_in[10]; a.w_down = (const float*)d_in[11]; a.fox_w_in = (const float*)d_in[12]; a.fox_b_f = (const float*)d_in[13];
    a.fox_q_norm_g = (const float*)d_in[14]; a.fox_k_norm_g = (const float*)d_in[15]; a.mla_w_in = (const float*)d_in[16]; a.mla_q_a_norm_g = (const float*)d_in[17];
    a.mla_w_q_b = (const float*)d_in[18]; a.mla_kv_a_norm_g = (const float*)d_in[19]; a.mla_w_kv_b = (const float*)d_in[20]; a.mla_q_norm_g = (const float*)d_in[21];
    a.mla_k_norm_g = (const float*)d_in[22];
    a.out = (float*)d_out; a.ws = (unsigned char*)d_ws;
    ArgsG ag{}; static_assert(sizeof(ag) == sizeof(a), ""); memcpy(&ag, &a, sizeof(a));
    hipLaunchKernelGGL(mk_fwd, dim3(grid), dim3(NWAVES * 64), LDS_BYTES, stream, ag);
}
```

```cpp
#include <hip/hip_runtime.h>
#include <cstdio>
#include <cstdint>
#include <cstring>

#define LAS __attribute__((address_space(3)))
#define GAS __attribute__((address_space(1)))
typedef unsigned short bf16;
typedef short bf16x8 __attribute__((ext_vector_type(8)));
typedef short s16x4 __attribute__((ext_vector_type(4)));
typedef float f32x2 __attribute__((ext_vector_type(2)));
typedef float f32x4 __attribute__((ext_vector_type(4)));
typedef float f32x8 __attribute__((ext_vector_type(8)));
typedef float f32x16 __attribute__((ext_vector_type(16)));
typedef unsigned u32x4 __attribute__((ext_vector_type(4)));
typedef unsigned u32x2 __attribute__((ext_vector_type(2)));

#ifndef HID_BLK
#define HID_BLK 1
#endif
#ifndef A_BLK
#define A_BLK 1
#endif
constexpr int NB = 4, SEQ = 4096, T = NB * SEQ, DM = 4096, NH = 24, FF = 16384, MLEN = 256, MT = NB * MLEN, NMH = 4;
constexpr int FOX_SRC = 10264, FOXN = 10496;
constexpr int MLA_SRC = 3136, MLAN = 3328;
constexpr int QLR = 1536, KVLR = 512, QBN = 4608, KVBN = 6144;
constexpr float EPS = 1e-6f, LOG2E = 1.4426950408889634f;
__device__ __forceinline__ size_t act_off(int row, int col, int M, int ld) { return A_BLK ? ((size_t)(col >> 6) * M + row) * 64 + (col & 63) : (size_t)row * ld + col; }

__device__ __forceinline__ int lane_id() { int l; asm volatile("v_mbcnt_lo_u32_b32 %0, -1, 0\n\tv_mbcnt_hi_u32_b32 %0, -1, %0" : "=v"(l)); return l; }
__device__ __forceinline__ int tid_of(int wv) { return (wv << 6) | lane_id(); }

namespace pg8 {
constexpr int BM = 256, BK = 64, HALF = 128, HTB = HALF * BK * 2, STAGE_BYTES = 8 * HTB, NXCD = 8, WGM = 8;
__host__ __device__ __forceinline__ int lds_byte(int r, int c) { const int st = (r >> 4) * 2 + (c >> 5), rr = r & 15, cc = c & 31, ob = rr * 64 + cc * 2; return st * 1024 + (ob ^ (((ob >> 9) & 1) << 5)); }
__host__ __device__ __forceinline__ void stage_rc(int b, int& R, int& C) { const int st = b / 1024, sb = b % 1024, swz = sb ^ (((sb >> 9) & 1) << 5); R = (st >> 1) * 16 + swz / 64; C = (st & 1) * 32 + (swz % 64) / 2; }
__host__ __device__ __forceinline__ int perm32(int rho) { const int n = rho >> 4, i = rho & 15; return 8 * (i >> 2) + 4 * n + (i & 3); }
struct Unit { int pm, pn; };
struct Gemm { const bf16* A; const bf16* Bt; int M, N, K; int bblk; int ablk; };
struct StaticOrder {
    int nM, nN, nwg, G, c;
    __device__ void init(int M, int N, int G_, int c_) { nM = M / BM; nN = N / BM; nwg = nM * nN; G = G_; c = c_; }
    __device__ bool next(int i, Unit& u) const {
        const long L = (long)i * G + c; if (L >= nwg) return false;
        int wgid = (int)L; { const int q = nwg / NXCD, r = nwg % NXCD, xcd = wgid % NXCD, off = wgid / NXCD; wgid = (xcd < r ? xcd * (q + 1) : r * (q + 1) + (xcd - r) * q) + off; }
        const int nig = WGM * nN, gid = wgid / nig, fm = gid * WGM, gsz = (nM - fm) < WGM ? (nM - fm) : WGM;
        u.pm = fm + ((wgid % nig) % gsz); u.pn = (wgid % nig) / gsz; return true;
    }
    __device__ __forceinline__ void a_ready(const Unit&) const {}
    __device__ __forceinline__ void done(const Unit&) const {}
};
typedef __bf16 bf16x2_t __attribute__((ext_vector_type(2)));
__device__ __forceinline__ unsigned cvt_pk_bf16(float lo, float hi) { const f32x2 v = {lo, hi}; const bf16x2_t b = __builtin_convertvector(v, bf16x2_t); return __builtin_bit_cast(unsigned, b); }

template <class Epi, class Sched, bool ALIGN_EPI = false, bool SP2 = false>
__device__ __forceinline__ void gemm_phase(LAS unsigned char* lds, const Gemm g, const Sched& S, const Epi& E, const int wv) {
    int tid = tid_of(wv); asm volatile("" : "+v"(tid));
    const int wid = __builtin_amdgcn_readfirstlane(tid >> 6), lane = tid & 63, wr = wid >> 2, wc = wid & 3, fr = lane & 15, fq = lane >> 4;
    const int K = g.K, nt = K / BK;
    unsigned voffA[2], voffB[2];
#pragma unroll
    for (int i = 0; i < 2; ++i) { int R, C; stage_rc(tid * 16 + i * 8192, R, C); const int Rb = Epi::PERM ? ((R & ~31) + perm32(R & 31)) : R;
        voffA[i] = (unsigned)(R * (g.ablk ? BK : K) + C) * 2u; voffB[i] = (unsigned)(Rb * (g.bblk ? BK : K) + C) * 2u; }
    const size_t kstep = (size_t)(BK * 2);
    const size_t hstep = (size_t)HALF * K * 2;
    const size_t tstep = 2 * hstep;
    const size_t kstepA = g.ablk ? (size_t)g.M * BK * 2 : kstep, hstepA = g.ablk ? (size_t)HALF * BK * 2 : hstep, tstepA = 2 * hstepA;
    const size_t kstepB = g.bblk ? (size_t)g.N * BK * 2 : kstep, hstepB = g.bblk ? (size_t)HALF * BK * 2 : hstep, tstepB = 2 * hstepB;
    const unsigned ldsw = (unsigned)wid * 1024u;
    const int aoff = lds_byte(wr * 64 + fr, fq * 8), boff = lds_byte(wc * 32 + fr, fq * 8);
#define PG8_SA(b, h) (((b) * 2 + (h)) * HTB)
#define PG8_SB(b, h) ((4 + (b) * 2 + (h)) * HTB)
#define PG8_STAGE(bufoff, gbase, voff) do { _Pragma("unroll") for (int _i = 0; _i < 2; ++_i) \
        __builtin_amdgcn_global_load_lds((const unsigned*)((const char*)(gbase) + (voff)[_i]), (LAS unsigned*)(lds + (bufoff) + ldsw + _i * 8192), 16, 0, 0); } while (0)
#define PG8_LDA(dst, b, h) do { _Pragma("unroll") for (int m = 0; m < 4; ++m) _Pragma("unroll") for (int k = 0; k < 2; ++k) dst[m][k] = *(const LAS bf16x8*)(lds + PG8_SA(b, h) + aoff + m * 2048 + k * 1024); } while (0)
#define PG8_LDB(dst, b, h) do { _Pragma("unroll") for (int n = 0; n < 2; ++n) _Pragma("unroll") for (int k = 0; k < 2; ++k) dst[n][k] = *(const LAS bf16x8*)(lds + PG8_SB(b, h) + boff + n * 2048 + k * 1024); } while (0)
#define PG8_MMA(ai, bj, At, Bt) do { __builtin_amdgcn_s_setprio(1); _Pragma("unroll") for (int m = 0; m < 4; ++m) _Pragma("unroll") for (int n = 0; n < 2; ++n) _Pragma("unroll") for (int k = 0; k < 2; ++k) \
        acc[ai][bj][m][n] = __builtin_amdgcn_mfma_f32_16x16x32_bf16(Bt[n][k], At[m][k], acc[ai][bj][m][n], 0, 0, 0); __builtin_amdgcn_s_setprio(0); } while (0)
#define PG8_WAIT_V(n) asm volatile("s_waitcnt vmcnt(" #n ")" ::: "memory")
#define PG8_WAIT_L(n) asm volatile("s_waitcnt lgkmcnt(" #n ")" ::: "memory")
#define PG8_BAR __builtin_amdgcn_s_barrier()
#define PG8_SCHED __builtin_amdgcn_sched_barrier(0)
    Unit cur, nxt; int ui = 0;
    if (!S.next(0, cur)) return;
    f32x4 acc[2][2][4][2];
#pragma unroll
    for (int a = 0; a < 2; ++a)
#pragma unroll
        for (int b = 0; b < 2; ++b)
#pragma unroll
            for (int m = 0; m < 4; ++m)
#pragma unroll
                for (int n = 0; n < 2; ++n) acc[a][b][m][n] = (f32x4){0.f, 0.f, 0.f, 0.f};
    bf16x8 At[4][2], B0[2][2], B1[2][2];
    const char* cA = (const char*)g.A + (size_t)cur.pm * tstepA; const char* cB = (const char*)g.Bt + (size_t)cur.pn * tstepB;
    S.a_ready(cur);
    if constexpr (SP2) {
        PG8_STAGE(PG8_SB(0, 0), cB, voffB); PG8_STAGE(PG8_SB(0, 1), cB + hstepB, voffB); PG8_STAGE(PG8_SA(0, 0), cA, voffA); PG8_STAGE(PG8_SA(0, 1), cA + hstepA, voffA);
        if (wr == 1) PG8_BAR;
        PG8_WAIT_V(2); PG8_BAR;
        PG8_STAGE(PG8_SB(1, 0), cB + kstepB, voffB); PG8_STAGE(PG8_SA(1, 0), cA + kstepA, voffA); PG8_STAGE(PG8_SB(1, 1), cB + hstepB + kstepB, voffB);
        PG8_WAIT_V(6); PG8_BAR;
    } else {
        PG8_STAGE(PG8_SB(0, 0), cB, voffB); PG8_STAGE(PG8_SA(0, 0), cA, voffA); PG8_STAGE(PG8_SB(0, 1), cB + hstepB, voffB); PG8_STAGE(PG8_SA(0, 1), cA + hstepA, voffA);
        if (wr == 1) PG8_BAR;
        PG8_WAIT_V(4); PG8_BAR;
        PG8_STAGE(PG8_SB(1, 0), cB + kstepB, voffB); PG8_STAGE(PG8_SA(1, 0), cA + kstepA, voffA); PG8_STAGE(PG8_SB(1, 1), cB + hstepB + kstepB, voffB);
        PG8_WAIT_V(6); PG8_BAR;
    }
    for (;;) {
        const bool has_next = S.next(ui + 1, nxt);
        const char* nA = has_next ? (const char*)g.A + (size_t)nxt.pm * tstepA : cA; const char* nB = has_next ? (const char*)g.Bt + (size_t)nxt.pn * tstepB : cB;
        for (int t = 0; t < nt; t += 2) {
            const bool last = (t == nt - 2);
            const char* a1 = cA + (size_t)(t + 1) * kstepA;
            const char* a2 = last ? nA : cA + (size_t)(t + 2) * kstepA; const char* b2 = last ? nB : cB + (size_t)(t + 2) * kstepB;
            const char* a3 = a2 + kstepA; const char* b3 = b2 + kstepB;
            if (last && has_next) S.a_ready(nxt);
            if constexpr (SP2) {
            PG8_LDB(B0, 0, 0); PG8_LDB(B1, 0, 1); PG8_SCHED; PG8_LDA(At, 0, 0); PG8_STAGE(PG8_SA(1, 1), a1 + hstepA, voffA);
            PG8_WAIT_V(8); PG8_WAIT_L(0); PG8_BAR; PG8_MMA(0, 0, At, B0); PG8_MMA(0, 1, At, B1); PG8_BAR; PG8_SCHED;
            PG8_LDA(At, 0, 1); PG8_STAGE(PG8_SB(0, 0), b2, voffB); PG8_STAGE(PG8_SB(0, 1), b2 + hstepB, voffB); PG8_STAGE(PG8_SA(0, 0), a2, voffA);
            PG8_WAIT_V(8); PG8_WAIT_L(0); PG8_BAR; PG8_MMA(1, 0, At, B0); PG8_MMA(1, 1, At, B1); PG8_BAR; PG8_SCHED;
            PG8_LDB(B0, 1, 0); PG8_LDB(B1, 1, 1); PG8_SCHED; PG8_LDA(At, 1, 0); PG8_STAGE(PG8_SA(0, 1), a2 + hstepA, voffA);
            PG8_WAIT_V(8); PG8_WAIT_L(0); PG8_BAR; PG8_MMA(0, 0, At, B0); PG8_MMA(0, 1, At, B1); PG8_BAR; PG8_SCHED;
            PG8_LDA(At, 1, 1); PG8_STAGE(PG8_SB(1, 0), b3, voffB); PG8_STAGE(PG8_SB(1, 1), b3 + hstepB, voffB); PG8_STAGE(PG8_SA(1, 0), a3, voffA);
            PG8_WAIT_V(8); PG8_WAIT_L(0); PG8_BAR; PG8_MMA(1, 0, At, B0); PG8_MMA(1, 1, At, B1); PG8_BAR; PG8_SCHED;
            } else {
            PG8_LDB(B0, 0, 0); PG8_SCHED; PG8_LDA(At, 0, 0); PG8_STAGE(PG8_SA(1, 1), a1 + hstepA, voffA);
            PG8_WAIT_L(8); PG8_BAR; PG8_WAIT_L(0); PG8_MMA(0, 0, At, B0); PG8_BAR; PG8_SCHED;
            PG8_LDB(B1, 0, 1); PG8_STAGE(PG8_SB(0, 0), b2, voffB);
            PG8_BAR; PG8_WAIT_L(0); PG8_MMA(0, 1, At, B1); PG8_BAR;
            PG8_LDA(At, 0, 1); PG8_STAGE(PG8_SA(0, 0), a2, voffA);
            PG8_BAR; PG8_WAIT_L(0); PG8_MMA(1, 0, At, B0); PG8_BAR; PG8_SCHED;
            PG8_STAGE(PG8_SB(0, 1), b2 + hstepB, voffB);
            PG8_WAIT_V(6); PG8_BAR; PG8_MMA(1, 1, At, B1); PG8_BAR;
            PG8_LDB(B0, 1, 0); PG8_SCHED; PG8_LDA(At, 1, 0); PG8_STAGE(PG8_SA(0, 1), a2 + hstepA, voffA);
            PG8_WAIT_L(8); PG8_BAR; PG8_WAIT_L(0); PG8_MMA(0, 0, At, B0); PG8_BAR; PG8_SCHED;
            PG8_LDB(B1, 1, 1); PG8_STAGE(PG8_SB(1, 0), b3, voffB);
            PG8_BAR; PG8_WAIT_L(0); PG8_MMA(0, 1, At, B1); PG8_BAR;
            PG8_LDA(At, 1, 1); PG8_STAGE(PG8_SA(1, 0), a3, voffA);
            PG8_BAR; PG8_WAIT_L(0); PG8_MMA(1, 0, At, B0); PG8_BAR; PG8_SCHED;
            PG8_STAGE(PG8_SB(1, 1), b3 + hstepB, voffB);
            PG8_WAIT_V(6); PG8_BAR; PG8_MMA(1, 1, At, B1); PG8_BAR;
            }
        }
        if constexpr (ALIGN_EPI) { if (wr == 0) PG8_BAR; }
        E(acc, cur, wr, wc, fr, fq); S.done(cur);
        if (!has_next) break;
#pragma unroll
        for (int a = 0; a < 2; ++a)
#pragma unroll
            for (int b = 0; b < 2; ++b)
#pragma unroll
                for (int m = 0; m < 4; ++m)
#pragma unroll
                    for (int n = 0; n < 2; ++n) acc[a][b][m][n] = (f32x4){0.f, 0.f, 0.f, 0.f};
        cur = nxt; cA = nA; cB = nB; ++ui;
        if constexpr (ALIGN_EPI) { if (wr == 1) PG8_BAR; }
    }
    PG8_WAIT_V(0);
    if constexpr (!ALIGN_EPI) { if (wr == 0) PG8_BAR; }
    PG8_BAR;
#undef PG8_SA
#undef PG8_SB
#undef PG8_STAGE
#undef PG8_LDA
#undef PG8_LDB
#undef PG8_MMA
#undef PG8_WAIT_V
#undef PG8_WAIT_L
#undef PG8_BAR
#undef PG8_SCHED
}
}
using pg8::Unit;

typedef f32x4 Acc[2][2][4][2];
__device__ __forceinline__ float red_fq(float s) {
    s += __int_as_float(__builtin_amdgcn_ds_swizzle(__float_as_int(s), 0x401F));
    auto rr = __builtin_amdgcn_permlane32_swap(__float_as_uint(s), __float_as_uint(s), false, false);
    return __uint_as_float(rr[0]) + __uint_as_float(rr[1]);
}
__device__ __forceinline__ float ss4(f32x4 a) { return (a[0] * a[0] + a[1] * a[1]) + (a[2] * a[2] + a[3] * a[3]); }
__device__ __forceinline__ u32x4 pack8(f32x4 a, f32x4 b) { u32x4 w; w.x = pg8::cvt_pk_bf16(a[0], a[1]); w.y = pg8::cvt_pk_bf16(a[2], a[3]); w.z = pg8::cvt_pk_bf16(b[0], b[1]); w.w = pg8::cvt_pk_bf16(b[2], b[3]); return w; }
__device__ __forceinline__ f32x4 ld4(const float* p) { return *(const f32x4*)p; }
__device__ __forceinline__ float logsig(float z) { return fminf(z, 0.f) - log1pf(expf(-fabsf(z))); }

struct EpiFoxIn {
    static constexpr bool PERM = true;
    bf16 *Q, *QM; size_t qkv_stride; float *qss, *kss, *mqss, *logf;
    const float *gq, *gk, *gmq, *gmk, *bfg; const LAS float* rtab; int rbase; LAS float* red;
    __device__ __forceinline__ void operator()(const Acc& acc, const Unit& u, int wr, int wc, int fr, int fq) const {
        const int pn = u.pn, rowb = u.pm * 256 + wr * 64 + fr, cw = wc * 32 + 8 * fq;
        if (pn < 36) {
            const int sec = pn / 12, hp = pn - sec * 12;
            bf16* base = Q + (size_t)sec * qkv_stride; float* ssb = sec ? kss : qss;
            f32x4 g0 = (f32x4){1.f, 1.f, 1.f, 1.f}, g1 = g0;
            if (sec == 0) { g0 = ld4(gq + cw) * ld4(gk + cw); g1 = ld4(gq + cw + 4) * ld4(gk + cw + 4); }
#pragma unroll
            for (int ai = 0; ai < 2; ++ai)
#pragma unroll
                for (int m = 0; m < 4; ++m) { const int row = rowb + ai * 128 + m * 16; const float rs = rtab[row - rbase];
#pragma unroll
                    for (int bj = 0; bj < 2; ++bj) { const int head = 2 * hp + bj; f32x4 v0 = acc[ai][bj][m][0] * rs, v1 = acc[ai][bj][m][1] * rs;
                        if (sec < 2) { const float s = red_fq(ss4(v0) + ss4(v1)); if (fq == 0) red[(((row & 255) * 2 + bj) << 2) + wc] = s; }
                        if (sec == 0) { v0 = v0 * g0; v1 = v1 * g1; }
                        *(u32x4*)(base + ((size_t)head * T + row) * 128 + cw) = pack8(v0, v1); } }
            if (sec < 2) {
                asm volatile("s_waitcnt lgkmcnt(0)" ::: "memory"); __builtin_amdgcn_s_barrier(); asm volatile("" ::: "memory");
                const int t_ = ((wr * 4 + wc) << 6) | (fq << 4) | fr, rl = t_ >> 1, bjt = t_ & 1;
                const f32x4 v = *(const LAS f32x4*)(red + ((rl * 2 + bjt) << 2));
                *(f32x4*)(ssb + ((size_t)(u.pm * 256 + rl) * NH + 2 * hp + bjt) * 4) = v; }
        } else if (pn < 40) {
            const int mh = pn - 36; f32x4 g[2][2];
#pragma unroll
            for (int bj = 0; bj < 2; ++bj) { const int d = 128 * bj + cw; g[bj][0] = ld4(gmq + d) * ld4(gmk + d); g[bj][1] = ld4(gmq + d + 4) * ld4(gmk + d + 4); }
#pragma unroll
            for (int ai = 0; ai < 2; ++ai)
#pragma unroll
                for (int m = 0; m < 4; ++m) { const int row = rowb + ai * 128 + m * 16; const float rs = rtab[row - rbase];
                    f32x4 v[2][2]; float s = 0.f;
#pragma unroll
                    for (int bj = 0; bj < 2; ++bj) { v[bj][0] = acc[ai][bj][m][0] * rs; v[bj][1] = acc[ai][bj][m][1] * rs; s += ss4(v[bj][0]) + ss4(v[bj][1]); }
                    s = red_fq(s); if (fq == 0) mqss[((size_t)row * NMH + mh) * 4 + wc] = s;
#pragma unroll
                    for (int bj = 0; bj < 2; ++bj) *(u32x4*)(QM + ((size_t)mh * T + row) * 256 + 128 * bj + cw) = pack8(v[bj][0] * g[bj][0], v[bj][1] * g[bj][1]); }
        } else {
            if (wc == 0 && fq < 3) {
                const f32x4 b0 = ld4(bfg + 8 * fq), b1 = ld4(bfg + 8 * fq + 4);
#pragma unroll
                for (int ai = 0; ai < 2; ++ai)
#pragma unroll
                    for (int m = 0; m < 4; ++m) { const int row = rowb + ai * 128 + m * 16; const float rs = rtab[row - rbase];
                        const f32x4 v0 = acc[ai][0][m][0] * rs + b0, v1 = acc[ai][0][m][1] * rs + b1;
                        float* lp = logf + ((size_t)(row >> 12) * NH + 8 * fq) * SEQ + (row & (SEQ - 1));
#pragma unroll
                        for (int e = 0; e < 4; ++e) { lp[(size_t)e * SEQ] = logsig(v0[e]); lp[(size_t)(e + 4) * SEQ] = logsig(v1[e]); } }
            }
        }
    }
};
__device__ __forceinline__ void rope8(f32x4& v0, f32x4& v1, const f32x4 g1, const f32x4 g2, const f32x4 cs, const f32x4 sn) {
    const f32x4 x1 = v0 * g1, x2 = v1 * g2; v0 = x1 * cs - x2 * sn; v1 = x2 * cs + x1 * sn;
}
struct EpiMlaIn {
    static constexpr bool PERM = true;
    bf16 *CQ, *CKV, *QM, *RK; float *cqss, *ckvss, *mqss, *krss;
    const float *gmq, *gmk, *gkn  , *cosT, *sinT; const LAS float* rtab; int rbase;
    __device__ __forceinline__ void operator()(const Acc& acc, const Unit& u, int wr, int wc, int fr, int fq) const {
        const int pn = u.pn, rowb = u.pm * 256 + wr * 64 + fr, cw = wc * 32 + 8 * fq;
        if (pn < 8) {
            const bool isq = pn < 6; bf16* base = isq ? CQ : CKV; const int ld = isq ? QLR : KVLR, cb = isq ? pn * 256 : (pn - 6) * 256;
            float* ssb = isq ? cqss + pn * 4 + wc : ckvss + (pn - 6) * 4 + wc; const int sst = isq ? 24 : 8;
#pragma unroll
            for (int ai = 0; ai < 2; ++ai)
#pragma unroll
                for (int m = 0; m < 4; ++m) { const int row = rowb + ai * 128 + m * 16; const float rs = rtab[row - rbase];
                    f32x4 v[2][2]; float s = 0.f;
#pragma unroll
                    for (int bj = 0; bj < 2; ++bj) { v[bj][0] = acc[ai][bj][m][0] * rs; v[bj][1] = acc[ai][bj][m][1] * rs; s += ss4(v[bj][0]) + ss4(v[bj][1]); }
                    s = red_fq(s); if (fq == 0) ssb[(size_t)row * sst] = s;
#pragma unroll
                    for (int bj = 0; bj < 2; ++bj) *(u32x4*)(base + act_off(row, cb + 128 * bj + cw, T, ld)) = pack8(v[bj][0], v[bj][1]); }
        } else if (pn < 12) {
            const int mh = pn - 8; f32x4 g[2][2];
#pragma unroll
            for (int bj = 0; bj < 2; ++bj) { const int d = 128 * bj + cw; g[bj][0] = ld4(gmq + d) * ld4(gmk + d); g[bj][1] = ld4(gmq + d + 4) * ld4(gmk + d + 4); }
#pragma unroll
            for (int ai = 0; ai < 2; ++ai)
#pragma unroll
                for (int m = 0; m < 4; ++m) { const int row = rowb + ai * 128 + m * 16; const float rs = rtab[row - rbase];
                    f32x4 v[2][2]; float s = 0.f;
#pragma unroll
                    for (int bj = 0; bj < 2; ++bj) { v[bj][0] = acc[ai][bj][m][0] * rs; v[bj][1] = acc[ai][bj][m][1] * rs; s += ss4(v[bj][0]) + ss4(v[bj][1]); }
                    s = red_fq(s); if (fq == 0) mqss[((size_t)row * NMH + mh) * 4 + wc] = s;
#pragma unroll
                    for (int bj = 0; bj < 2; ++bj) *(u32x4*)(QM + ((size_t)mh * T + row) * 256 + 128 * bj + cw) = pack8(v[bj][0] * g[bj][0], v[bj][1] * g[bj][1]); }
        } else {
            if (wc < 2) {
                const int i0 = 16 * wc + 4 * fq; const f32x4 g1 = ld4(gkn + 128 + i0), g2 = ld4(gkn + 160 + i0);
#pragma unroll
                for (int ai = 0; ai < 2; ++ai)
#pragma unroll
                    for (int m = 0; m < 4; ++m) { const int row = rowb + ai * 128 + m * 16; const float rs = rtab[row - rbase];
                        f32x4 v0 = acc[ai][0][m][0] * rs, v1 = acc[ai][0][m][1] * rs;
                        const float s = red_fq(ss4(v0) + ss4(v1)); if (fq == 0) krss[(size_t)row * 2 + wc] = s;
                        rope8(v0, v1, g1, g2, ld4(cosT + (size_t)row * 32 + i0), ld4(sinT + (size_t)row * 32 + i0));
                        *(u32x4*)(RK + (size_t)row * 64 + 32 * wc + 8 * fq) = pack8(v0, v1); }
            }
        }
    }
};
struct EpiQB {
    static constexpr bool PERM = true;
    bf16 *QN, *QR; float* qss; const float *gq, *gk, *cosT, *sinT; const LAS float* rtab; int rbase;
    __device__ __forceinline__ void operator()(const Acc& acc, const Unit& u, int wr, int wc, int fr, int fq) const {
        const int pn = u.pn, rowb = u.pm * 256 + wr * 64 + fr, cw = wc * 32 + 8 * fq;
        if (pn < 12) {
            const f32x4 g0 = ld4(gq + cw) * ld4(gk + cw), g1 = ld4(gq + cw + 4) * ld4(gk + cw + 4);
#pragma unroll
            for (int ai = 0; ai < 2; ++ai)
#pragma unroll
                for (int m = 0; m < 4; ++m) { const int row = rowb + ai * 128 + m * 16; const float rs = rtab[row - rbase];
#pragma unroll
                    for (int bj = 0; bj < 2; ++bj) { const int head = 2 * pn + bj; const f32x4 v0 = acc[ai][bj][m][0] * rs, v1 = acc[ai][bj][m][1] * rs;
                        const float s = red_fq(ss4(v0) + ss4(v1)); if (fq == 0) qss[((size_t)row * NH + head) * 8 + wc] = s;
                        *(u32x4*)(QN + ((size_t)head * T + row) * 128 + cw) = pack8(v0 * g0, v1 * g1); } }
        } else {
            const int t = pn - 12, wl = wc & 1, i0 = 16 * wl + 4 * fq; const f32x4 g1 = ld4(gq + 128 + i0), g2 = ld4(gq + 160 + i0);
#pragma unroll
            for (int ai = 0; ai < 2; ++ai)
#pragma unroll
                for (int m = 0; m < 4; ++m) { const int row = rowb + ai * 128 + m * 16; const float rs = rtab[row - rbase];
                    const f32x4 cs = ld4(cosT + (size_t)row * 32 + i0), sn = ld4(sinT + (size_t)row * 32 + i0);
#pragma unroll
                    for (int bj = 0; bj < 2; ++bj) { const int head = 4 * t + 2 * bj + (wc >> 1); f32x4 v0 = acc[ai][bj][m][0] * rs, v1 = acc[ai][bj][m][1] * rs;
                        const float s = red_fq(ss4(v0) + ss4(v1)); if (fq == 0) qss[((size_t)row * NH + head) * 8 + 4 + wl] = s;
                        rope8(v0, v1, g1, g2, cs, sn);
                        *(u32x4*)(QR + ((size_t)head * T + row) * 64 + 32 * wl + 8 * fq) = pack8(v0, v1); } }
        }
    }
};
struct EpiKVB {
    static constexpr bool PERM = true;
    bf16 *KN, *VV; float* kss; const LAS float* rtab; int rbase;
    __device__ __forceinline__ void operator()(const Acc& acc, const Unit& u, int wr, int wc, int fr, int fq) const {
        const int pn = u.pn, rowb = u.pm * 256 + wr * 64 + fr, cw = wc * 32 + 8 * fq; const bool isk = pn < 12; const int hp = isk ? pn : pn - 12; bf16* base = isk ? KN : VV;
#pragma unroll
        for (int ai = 0; ai < 2; ++ai)
#pragma unroll
            for (int m = 0; m < 4; ++m) { const int row = rowb + ai * 128 + m * 16; const float rs = rtab[row - rbase];
#pragma unroll
                for (int bj = 0; bj < 2; ++bj) { const int head = 2 * hp + bj; const f32x4 v0 = acc[ai][bj][m][0] * rs, v1 = acc[ai][bj][m][1] * rs;
                    if (isk) { const float s = red_fq(ss4(v0) + ss4(v1)); if (fq == 0) kss[((size_t)row * NH + head) * 4 + wc] = s; }
                    *(u32x4*)(base + ((size_t)head * T + row) * 128 + cw) = pack8(v0, v1); } }
    }
};
struct EpiMemKV {
    static constexpr bool PERM = true;
    bf16 *MK, *MV; float* mkss; const LAS float* rtab; int rbase;
    __device__ __forceinline__ void operator()(const Acc& acc, const Unit& u, int wr, int wc, int fr, int fq) const {
        const int pn = u.pn, rowb = u.pm * 256 + wr * 64 + fr, cw = wc * 32 + 8 * fq; const bool isk = pn < 4; const int mh = isk ? pn : pn - 4; bf16* base = isk ? MK : MV;
#pragma unroll
        for (int ai = 0; ai < 2; ++ai)
#pragma unroll
            for (int m = 0; m < 4; ++m) { const int row = rowb + ai * 128 + m * 16; const float rs = rtab[row - rbase];
                f32x4 v[2][2]; float s = 0.f;
#pragma unroll
                for (int bj = 0; bj < 2; ++bj) { v[bj][0] = acc[ai][bj][m][0] * rs; v[bj][1] = acc[ai][bj][m][1] * rs; s += ss4(v[bj][0]) + ss4(v[bj][1]); }
                if (isk) { s = red_fq(s); if (fq == 0) mkss[((size_t)mh * MT + row) * 4 + wc] = s; }
#pragma unroll
                for (int bj = 0; bj < 2; ++bj) *(u32x4*)(base + (size_t)row * 1024 + mh * 256 + 128 * bj + cw) = pack8(v[bj][0], v[bj][1]); }
    }
};
__device__ __forceinline__ f32x4 bf2f_lo(u32x2 w) { return (f32x4){__uint_as_float(w.x << 16), __uint_as_float(w.x & 0xffff0000u), __uint_as_float(w.y << 16), __uint_as_float(w.y & 0xffff0000u)}; }
template <bool LAST> struct EpiRes {
    static constexpr bool PERM = true;
    const bf16* XBr; bf16* XB; float* out; float* rss;
    __device__ __forceinline__ void operator()(const Acc& acc, const Unit& u, int wr, int wc, int fr, int fq) const {
        const int pn = u.pn, rowb = u.pm * 256 + wr * 64 + fr, cw = wc * 32 + 8 * fq;
#pragma unroll
        for (int ai = 0; ai < 2; ++ai)
#pragma unroll
            for (int m = 0; m < 4; ++m) { const int row = rowb + ai * 128 + m * 16; float s = 0.f;
#pragma unroll
                for (int bj = 0; bj < 2; ++bj) { const size_t o = (size_t)row * DM + pn * 256 + 128 * bj + cw, ob = act_off(row, pn * 256 + 128 * bj + cw, T, DM);
                    const u32x4 xr = *(const u32x4*)(XBr + ob);
                    const f32x4 v0 = bf2f_lo((u32x2){xr.x, xr.y}) + acc[ai][bj][m][0], v1 = bf2f_lo((u32x2){xr.z, xr.w}) + acc[ai][bj][m][1];
                    if (LAST) { *(f32x4*)(out + o) = v0; *(f32x4*)(out + o + 4) = v1; }
                    else { s += ss4(v0) + ss4(v1); *(u32x4*)(XB + ob) = pack8(v0, v1); } }
                if (!LAST) { s = red_fq(s); if (fq == 0) rss[(size_t)row * 64 + pn * 4 + wc] = s; } }
    }
};
struct EpiUp {
    static constexpr bool PERM = true;
    bf16* HID; const LAS float* rtab; int rbase;
    __device__ __forceinline__ void operator()(const Acc& acc, const Unit& u, int wr, int wc, int fr, int fq) const {
        const int pn = u.pn, rowb = u.pm * 256 + wr * 64 + fr, cw = wc * 32 + 8 * fq;
#pragma unroll
        for (int ai = 0; ai < 2; ++ai)
#pragma unroll
            for (int m = 0; m < 4; ++m) { const int row = rowb + ai * 128 + m * 16; const float rs = rtab[row - rbase];
#pragma unroll
                for (int bj = 0; bj < 2; ++bj) { f32x4 v0 = acc[ai][bj][m][0] * rs, v1 = acc[ai][bj][m][1] * rs;
#pragma unroll
                    for (int e = 0; e < 4; ++e) { const float a = fmaxf(v0[e], 0.f), b = fmaxf(v1[e], 0.f); v0[e] = a * a; v1[e] = b * b; }
                    { const int col = pn * 256 + 128 * bj + cw;
                      *(u32x4*)(HID + (HID_BLK ? ((size_t)(col >> 6) * T + row) * 64 + (col & 63) : (size_t)row * FF + col)) = pack8(v0, v1); } } }
    }
};

namespace att {
constexpr int SHM_V = 64 * 128 * 2;
constexpr int L_V = 0, L_K = 49152, L_WS = 155648, L_SC = 157696;
constexpr int l_rk(int dk) { return L_K + 3 * 64 * dk * 2; }
constexpr int l_dl(int dk) { return l_rk(dk) + 16384; }
static_assert(l_dl(128) + 16384 <= L_WS && l_rk(192) + 16384 <= L_WS && l_rk(256) + 1024 <= L_WS, "attention LDS map");
__device__ __forceinline__ int v_st(int k, int c) { const int kk = (k & ~0xC) | ((k & 4) << 1) | ((k & 8) >> 1); return ((kk >> 3) * 4 + (c >> 5)) * 512 + ((kk & 7) * 32 + (c & 31)) * 2; }
__device__ __forceinline__ int v_rd_base(int lane) { return ((lane & 3) << 3) | (((lane >> 2) & 3) << 6) | (((lane >> 4) & 1) << 5) | (((lane >> 5) & 1) << 8); }
constexpr int v_rd_off(int d0, int ks, int half) { return d0 * 512 + ks * 4096 + half * 2048; }
__device__ __forceinline__ int crow(int r, int hi) { return (r & 3) + 8 * (r >> 2) + 4 * hi; }
__device__ __forceinline__ unsigned cvtpk(float lo, float hi) { return pg8::cvt_pk_bf16(lo, hi); }
#define SBAR() __builtin_amdgcn_sched_barrier(0)
__device__ __forceinline__ float fmul_s(float a, float b) { return a * b; }
__device__ __forceinline__ float fadd_s(float a, float b) { return a + b; }
__device__ __forceinline__ float fsub_s(float a, float b) { return a - b; }
__device__ __forceinline__ float ffma_s(float a, float b, float c) { return __builtin_fmaf(a, b, c); }

struct Blk {
    const bf16 *Qa, *Qb;
    const bf16 *Ka, *Kb;
    const bf16* V;
    bf16* O; int orow0, ocol0;
    const float* qssp;
    int nkt;
    int nrun;
    int qpos0;
};
template <int QPA, int QPB, int KPA, int KPB, int VP, int QSTR> struct Pitch { static constexpr int qpa = QPA, qpb = QPB, kpa = KPA, kpb = KPB, vp = VP, qstr = QSTR; };

template <int DK, int DKA, int NQS, bool CAUSAL, bool BIAS, bool QREG, bool REV, class P>
__device__ __forceinline__ void attn_block(char* lds, const Blk& B, const int wv) {
    constexpr int SWA = (DKA == 128) ? 15 : 7, NKBP = (SWA + 1) / 2;
    constexpr int RSA = DKA * 2, RSB = 128, SHM_K = 64 * DK * 2, KB_OFF = 64 * RSA, NPA = DKA / 64, ND = DK / 16, NDA = DKA / 16; constexpr bool HASB = DK > DKA;
    constexpr int NP = NPA + (HASB ? 1 : 0) + 2;
    static_assert(!HASB || DK - DKA == 64, "region B is 64 dims");
    int tid = tid_of(wv); asm volatile("" : "+v"(tid));
    const int wid = __builtin_amdgcn_readfirstlane(tid >> 6), lane = tid & 63, r32 = lane & 31, hi = lane >> 5, grp = wid >> 2;
    LAS unsigned char* ldsl = (LAS unsigned char*)lds;
    char* V_lds = lds + L_V; char* K_lds = lds + L_K;
    const float* DL = (const float*)(lds + l_dl(DK)); const float* RKt = (const float*)(lds + l_rk(DK));
    const int qrow = wid * 32 + r32;
    const unsigned qoa = (unsigned)(qrow * P::qpa + hi * 8) * 2u, qob = (unsigned)(qrow * P::qpb + hi * 8) * 2u;
#define QFRAG(d0) ((d0) < NDA ? *(const bf16x8*)((const char*)B.Qa + (qoa + (d0) * 32)) : *(const bf16x8*)((const char*)B.Qb + (qob + ((d0) - NDA) * 32)))
    float rq;
    { const float* qp = B.qssp + (size_t)qrow * P::qstr; const f32x4 a = ld4(qp); float s = (a[0] + a[1]) + (a[2] + a[3]);
      if (NQS == 6) { const f32x2 b = *(const f32x2*)(qp + 4); s += b[0] + b[1]; }
      rq = rsqrtf(s * (1.f / DK) + EPS); }
    bf16x8 qr[QREG ? ND : 1];
    if (QREG) {
#pragma unroll
        for (int d0 = 0; d0 < ND; ++d0) { const bf16x8 raw = QFRAG(d0); const u32x4 w = *reinterpret_cast<const u32x4*>(&raw); u32x4 o_;
#pragma unroll
            for (int e = 0; e < 4; ++e) o_[e] = cvtpk(__uint_as_float(w[e] << 16) * rq, __uint_as_float(w[e] & 0xffff0000u) * rq);
            qr[QREG ? d0 : 0] = *reinterpret_cast<const bf16x8*>(&o_); } }
    const float rqs = QREG ? 1.f : rq;
    const int qlo = B.qpos0 + wid * 32, qpos = qlo + r32;
    constexpr int NKA = 2 * NPA, NKB = HASB ? 2 : 0, NK_ = NKA + NKB, NVP = 4;
    const int lw = wid & 3;
    static_assert((4096 / RSA) % (SWA + 1) == 0 && (4096 / RSB) % 8 == 0, "piece stride keeps the swizzle phase");
    unsigned kva0, kvb0 = 0u, vva0;
    { const int b = lw * 1024 + lane * 16, krow = b / RSA, x = b % RSA, kc = (x ^ ((krow & SWA) << 4)) >> 4; kva0 = (unsigned)(krow * P::kpa + kc * 8) * 2u; }
    if (HASB) { const int b = lw * 1024 + lane * 16, krow = b / RSB, x = b % RSB, kc = (x ^ ((krow & 7) << 4)) >> 4; kvb0 = (unsigned)(krow * P::kpb + kc * 8) * 2u; }
    { const int b = lw * 1024 + lane * 16, sub = b >> 9, w = (b & 511) >> 1, kk = (sub >> 2) * 8 + (w >> 5), c = (sub & 3) * 32 + (w & 31);
      const int k = (kk & ~0xC) | ((kk & 4) << 1) | ((kk & 8) >> 1); vva0 = (unsigned)(k * P::vp + c) * 2u; }
    constexpr unsigned PSA = (unsigned)((4096 / RSA) * P::kpa) * 2u, PSB = (unsigned)((4096 / RSB) * P::kpb) * 2u, PSV = (unsigned)(16 * P::vp) * 2u;
    const unsigned tsa = (unsigned)(64 * P::kpa) * 2u, tsb = (unsigned)(64 * P::kpb) * 2u, tsv = (unsigned)(64 * P::vp) * 2u;
    const int vb0 = (int)(uintptr_t)V_lds + v_rd_base(lane);
#define DMA16(gp, ldsoff) __builtin_amdgcn_global_load_lds((const unsigned*)(gp), (LAS unsigned*)(ldsl + (ldsoff)), 16, 0, 0)
#define LOADK(t_, bf) do { _Pragma("unroll") for (int i = 0; i < NKA; ++i) DMA16((const char*)B.Ka + ((size_t)(unsigned)(t_) * tsa + i * PSA) + kva0, L_K + (bf) * SHM_K + (lw + 4 * i) * 1024); \
        if (HASB) { _Pragma("unroll") for (int i = 0; i < 2; ++i) DMA16((const char*)B.Kb + ((size_t)(unsigned)(t_) * tsb + i * PSB) + kvb0, L_K + (bf) * SHM_K + KB_OFF + (lw + 4 * i) * 1024); } } while (0)
#define LOADV(t_, bf) do { _Pragma("unroll") for (int i = 0; i < NVP; ++i) DMA16((const char*)B.V + ((size_t)(unsigned)(t_) * tsv + i * PSV) + vva0, L_V + (bf) * SHM_V + (lw + 4 * i) * 1024); } while (0)
#define VMWAIT(n) asm volatile("s_waitcnt vmcnt(%0)" :: "n"(n) : "memory")
#define WGBAR() do { asm volatile("" ::: "memory"); __builtin_amdgcn_s_barrier(); asm volatile("" ::: "memory"); } while (0)
    constexpr float DEFER_THR = 8.f;
    float m_reg = 0.f, l_reg = 0.f; f32x16 o[4] = {};
    const int nkt = B.nkt, nrun = B.nrun;
#define KT(t_) (REV ? nkt - 1 - (t_) : (t_))
    if (!grp) { LOADK(KT(0), 0); LOADV(KT(0), 0); LOADK(KT(1), 1); LOADV(KT(1), 1); VMWAIT(NVP + NK_ + NVP); }
    WGBAR();
    if (grp) WGBAR();
#define SCALE(P, kk_) do { _Pragma("unroll") for (int g = 0; g < 4; ++g) { \
            f32x4 rk_ = ld4(RKt + (kk_) + 8 * g); if (!QREG) { _Pragma("unroll") for (int j = 0; j < 4; ++j) rk_[j] = fmul_s(rk_[j], rqs); } \
            if (BIAS) { const f32x4 nd_ = ld4(DL + (kk_) + 8 * g) - m_reg; \
                _Pragma("unroll") for (int j = 0; j < 4; ++j) P[4 * g + j] = ffma_s(P[4 * g + j], rk_[j], nd_[j]); } \
            else { const float nm_ = -m_reg; _Pragma("unroll") for (int j = 0; j < 4; ++j) P[4 * g + j] = ffma_s(P[4 * g + j], rk_[j], nm_); } } } while (0)
#define MASK1(P, r_, c_) asm volatile("v_cmp_lt_i32 vcc, %1, %2\n\tv_cndmask_b32 %0, %0, %3, vcc" : "+v"(P[r_]) : "v"(dqk), "n"(c_), "v"(NEG) : "vcc")
#define TRRD(dst, off) asm volatile("ds_read_b64_tr_b16 %0, %1 offset:%2" : "=&v"(dst) : "v"(vb0), "i"(off) : "memory")
#define LGK(n) do { asm volatile("s_waitcnt lgkmcnt(" #n ")" ::: "memory"); SBAR(); } while (0)
#define VLD(S, VB, ks) do { constexpr int b_ = (VB) * SHM_V + (ks) * 4096; \
        TRRD(S##l0, b_); TRRD(S##h0, b_ + 2048); TRRD(S##l1, b_ + 512); TRRD(S##h1, b_ + 2560); TRRD(S##l2, b_ + 1024); TRRD(S##h2, b_ + 3072); TRRD(S##l3, b_ + 1536); TRRD(S##h3, b_ + 3584); } while (0)
#define MM(S, d0, PA) o[d0] = __builtin_amdgcn_mfma_f32_32x32x16_bf16((bf16x8){S##l##d0[0], S##l##d0[1], S##l##d0[2], S##l##d0[3], S##h##d0[0], S##h##d0[1], S##h##d0[2], S##h##d0[3]}, PA, o[d0], 0, 0, 0)
#define EXS(P, B_, j, CV) do { P[B_ + 2 * (j)] = __builtin_amdgcn_exp2f(P[B_ + 2 * (j)]); P[B_ + 2 * (j) + 1] = __builtin_amdgcn_exp2f(P[B_ + 2 * (j) + 1]); \
        ps += P[B_ + 2 * (j)] + P[B_ + 2 * (j) + 1]; CV = cvtpk(P[B_ + 2 * (j)], P[B_ + 2 * (j) + 1]); } while (0)
#define PKQ(OUT) do { auto r0 = __builtin_amdgcn_permlane32_swap(a0, b0, false, false); auto r1 = __builtin_amdgcn_permlane32_swap(a1, b1, false, false); \
        u32x4 w = {r0[0], r1[0], r0[1], r1[1]}; OUT = *reinterpret_cast<bf16x8*>(&w); } while (0)
#define EXP2(P, i0) do { P[i0] = __builtin_amdgcn_exp2f(P[i0]); P[(i0) + 1] = __builtin_amdgcn_exp2f(P[(i0) + 1]); } while (0)
#define ACC2(P, i0, CV) do { ps += P[i0]; ps += P[(i0) + 1]; CV = cvtpk(P[i0], P[(i0) + 1]); } while (0)
#define QBODY(S, PA, P, B_) \
        MM(S, 0, PA); EXP2(P, B_); SBAR(); \
        MM(S, 1, PA); EXP2(P, B_ + 2); ACC2(P, B_, a0); SBAR(); \
        MM(S, 2, PA); EXP2(P, B_ + 4); ACC2(P, B_ + 2, a1); SBAR(); \
        MM(S, 3, PA); EXP2(P, B_ + 6); ACC2(P, B_ + 4, b0); SBAR()
#define QTAIL(P, B_, OUT) do { ACC2(P, B_ + 6, b1); PKQ(OUT); SBAR(); } while (0)
#define KFR(BUF, i_, h_) (*reinterpret_cast<const bf16x8*>((i_) < NDA ? kbp[(i_) % NKBP] + ((i_) / NKBP) * (NKBP * 32) + (h_) * 32 * RSA \
        : K_lds + (BUF) * SHM_K + KB_OFF + (r32 + (h_) * 32) * RSB + (((((i_) - NDA) * 16 + hi * 8) * 2) ^ ((r32 & 7) << 4))))
#define SCALE2(P, RK_, DL_) do { _Pragma("unroll") for (int g = 0; g < 4; ++g) { \
            if (BIAS) { const f32x4 nd_ = DL_[g] - m_reg; _Pragma("unroll") for (int j = 0; j < 4; ++j) P[4 * g + j] = ffma_s(P[4 * g + j], RK_[g][j], nd_[j]); } \
            else { const float nm_ = -m_reg; _Pragma("unroll") for (int j = 0; j < 4; ++j) P[4 * g + j] = ffma_s(P[4 * g + j], RK_[g][j], nm_); } } } while (0)
#define STEP(BUF, t_) do { const int kb_ = KT(t_) * 64; \
        const bool act_ = !(CAUSAL && kb_ > qlo + 31);        \
          \
          \
        bf16x8 qt[QREG ? 1 : ND]; if (!QREG) { _Pragma("unroll") for (int d0 = 0; d0 < ND; ++d0) qt[QREG ? 0 : d0] = QFRAG(d0); asm volatile("" :: "v"(qt[QREG ? 0 : ND - 1]) : "memory"); }     \
        if (!grp && (t_) + 2 < nrun) LOADK(KT((t_) + 2), ((BUF) + 2) % 3); \
        f32x16 p0 = {}, p1 = {}; SBAR(); \
        if (act_) { const char* kbp[NKBP]; _Pragma("unroll") for (int dd = 0; dd < NKBP; ++dd) kbp[dd] = K_lds + (BUF) * SHM_K + r32 * RSA + (((dd * 16 + hi * 8) * 2) ^ ((r32 & SWA) << 4)); \
          if constexpr (QREG) { \
            \
            \
            \
          constexpr int RD = 8; \
          bf16x8 ka_[RD], kb2_[RD]; f32x4 rkA[4], rkB[4], dlA[4] = {}, dlB[4] = {}; const int kk0_ = kb_ + 4 * hi; \
          _Pragma("unroll") for (int s_ = 0; s_ < RD; ++s_) { ka_[s_] = KFR(BUF, s_, 0); kb2_[s_] = KFR(BUF, s_, 1); } \
          SBAR(); \
          _Pragma("unroll") for (int d0 = 0; d0 < ND; ++d0) { \
            p0 = __builtin_amdgcn_mfma_f32_32x32x16_bf16(ka_[d0 % RD], qr[QREG ? d0 : 0], p0, 0, 0, 0); p1 = __builtin_amdgcn_mfma_f32_32x32x16_bf16(kb2_[d0 % RD], qr[QREG ? d0 : 0], p1, 0, 0, 0); \
            if (d0 + RD < ND) { ka_[d0 % RD] = KFR(BUF, d0 + RD, 0); kb2_[d0 % RD] = KFR(BUF, d0 + RD, 1); } \
            if (d0 == ND - 4) { _Pragma("unroll") for (int g = 0; g < 4; ++g) { rkA[g] = ld4(RKt + kk0_ + 8 * g); if (BIAS) dlA[g] = ld4(DL + kk0_ + 8 * g); } } \
            if (d0 == ND - 2) { _Pragma("unroll") for (int g = 0; g < 4; ++g) { rkB[g] = ld4(RKt + kk0_ + 32 + 8 * g); if (BIAS) dlB[g] = ld4(DL + kk0_ + 32 + 8 * g); } } \
            SBAR(); } \
          SCALE2(p0, rkA, dlA); SCALE2(p1, rkB, dlB); \
          } else { \
          _Pragma("unroll") for (int d0 = 0; d0 < NDA; ++d0) { const char* a_ = kbp[d0 % NKBP] + (d0 / NKBP) * (NKBP * 32); \
            const bf16x8 b0_ = *reinterpret_cast<const bf16x8*>(a_), b1_ = *reinterpret_cast<const bf16x8*>(a_ + 32 * RSA); \
            const bf16x8 q_ = QREG ? qr[QREG ? d0 : 0] : qt[QREG ? 0 : d0]; \
            p0 = __builtin_amdgcn_mfma_f32_32x32x16_bf16(b0_, q_, p0, 0, 0, 0); p1 = __builtin_amdgcn_mfma_f32_32x32x16_bf16(b1_, q_, p1, 0, 0, 0); if (!QREG && (d0 & 3) == 3) SBAR(); } \
          if (HASB) { _Pragma("unroll") for (int e = 0; e < 4; ++e) { const char* a_ = K_lds + (BUF) * SHM_K + KB_OFF + r32 * RSB + (((e * 16 + hi * 8) * 2) ^ ((r32 & 7) << 4)); \
            const bf16x8 b0_ = *reinterpret_cast<const bf16x8*>(a_), b1_ = *reinterpret_cast<const bf16x8*>(a_ + 32 * RSB); \
            const bf16x8 q_ = QREG ? qr[QREG ? NDA + e : 0] : qt[QREG ? 0 : NDA + e]; \
            p0 = __builtin_amdgcn_mfma_f32_32x32x16_bf16(b0_, q_, p0, 0, 0, 0); p1 = __builtin_amdgcn_mfma_f32_32x32x16_bf16(b1_, q_, p1, 0, 0, 0); } } \
        SBAR(); SCALE(p0, kb_ + 4 * hi); SCALE(p1, kb_ + 32 + 4 * hi); } } SBAR(); \
        if (!grp) { if ((t_) + 2 < nrun) VMWAIT(2 * NK_ + NVP); else if ((t_) + 1 < nrun) VMWAIT(NK_ + NVP); else VMWAIT(0); }     \
        WGBAR(); \
          \
        if (!grp && (t_) + 2 < nrun) LOADV(KT((t_) + 2), ((BUF) + 2) % 3); \
        if (act_) { \
        if (CAUSAL && kb_ + 63 > qlo) { const float NEG = -__builtin_inff(); const int dqk = qpos - kb_ - 4 * hi; \
            _Pragma("unroll") for (int r = 0; r < 16; ++r) { MASK1(p0, r, (r & 3) + 8 * (r >> 2)); MASK1(p1, r, (r & 3) + 8 * (r >> 2) + 32); } } \
        float pmax = fmaxf(fmaxf(p0[0], p0[1]), p1[0]); \
        _Pragma("unroll") for (int r = 2; r < 16; r += 2) pmax = fmaxf(fmaxf(pmax, p0[r]), p0[r + 1]); \
        _Pragma("unroll") for (int r = 1; r < 15; r += 2) pmax = fmaxf(fmaxf(pmax, p1[r]), p1[r + 1]); \
        pmax = fmaxf(pmax, p1[15]); \
        { auto rr = __builtin_amdgcn_permlane32_swap(__float_as_uint(pmax), __float_as_uint(pmax), false, false); pmax = fmaxf(__uint_as_float(rr[0]), __uint_as_float(rr[1])); } \
          \
          \
        if (!__all(pmax <= DEFER_THR)) { const float dl_ = fmaxf(pmax, 0.f); const float alpha = __builtin_amdgcn_exp2f(-dl_); m_reg += dl_; l_reg *= alpha; \
            _Pragma("unroll") for (int r = 0; r < 16; ++r) { p0[r] = fsub_s(p0[r], dl_); p1[r] = fsub_s(p1[r], dl_); } \
            _Pragma("unroll") for (int d_ = 0; d_ < 4; ++d_) _Pragma("unroll") for (int r = 0; r < 16; ++r) o[d_][r] = fmul_s(o[d_][r], alpha); } \
          \
          \
        float ps = 0.f; bf16x8 pa0, pa1, pa2, pa3; \
        s16x4 Al0, Al1, Al2, Al3, Ah0, Ah1, Ah2, Ah3, Bl0, Bl1, Bl2, Bl3, Bh0, Bh1, Bh2, Bh3; \
        SBAR(); asm volatile("s_waitcnt lgkmcnt(0)" ::: "memory");     \
        VLD(A, BUF, 0); SBAR(); \
        { unsigned a0, a1, b0, b1; EXS(p0, 0, 0, a0); EXS(p0, 0, 1, a1); EXS(p0, 0, 2, b0); EXS(p0, 0, 3, b1); PKQ(pa0); } SBAR(); \
        VLD(B, BUF, 1); LGK(8); \
        { unsigned a0, a1, b0, b1; QBODY(A, pa0, p0, 8); VLD(A, BUF, 2); SBAR(); QTAIL(p0, 8, pa1); } LGK(8); \
        { unsigned a0, a1, b0, b1; QBODY(B, pa1, p1, 0); VLD(B, BUF, 3); SBAR(); QTAIL(p1, 0, pa2); } LGK(8); \
        { unsigned a0, a1, b0, b1; QBODY(A, pa2, p1, 8); SBAR(); QTAIL(p1, 8, pa3); } \
        LGK(0); MM(B, 0, pa3); MM(B, 1, pa3); MM(B, 2, pa3); MM(B, 3, pa3); \
        { auto rr = __builtin_amdgcn_permlane32_swap(__float_as_uint(ps), __float_as_uint(ps), false, false); ps = __uint_as_float(rr[0]) + __uint_as_float(rr[1]); } \
        l_reg += ps; } SBAR(); \
        if (!grp) { if ((t_) + 2 < nrun) VMWAIT(NVP + NK_ + NVP); else if ((t_) + 1 < nrun) VMWAIT(NVP); else VMWAIT(0); }     \
        WGBAR(); } while (0)
#define PK4(P, B_, OUT) do { const unsigned a0 = cvtpk(P[B_ + 0], P[B_ + 1]), a1 = cvtpk(P[B_ + 2], P[B_ + 3]); \
        const unsigned b0 = cvtpk(P[B_ + 4], P[B_ + 5]), b1 = cvtpk(P[B_ + 6], P[B_ + 7]); \
        auto r0 = __builtin_amdgcn_permlane32_swap(a0, b0, false, false); auto r1 = __builtin_amdgcn_permlane32_swap(a1, b1, false, false); \
        u32x4 w = {r0[0], r1[0], r0[1], r1[1]}; OUT = *reinterpret_cast<bf16x8*>(&w); } while (0)
    for (int t = 0; t < nrun; t += 3) { STEP(0, t); if (t + 1 < nrun) STEP(1, t + 1); if (t + 2 < nrun) STEP(2, t + 2); }
    if (!grp) WGBAR();
#undef PK4
#undef STEP
#undef SCALE2
#undef KFR
#undef QTAIL
#undef QBODY
#undef ACC2
#undef EXP2
#undef PKQ
#undef EXS
#undef MM
#undef VLD
#undef LGK
#undef TRRD
#undef MASK1
#undef KT
#undef SCALE
#undef LOADV
#undef LOADK
#undef DMA16
#undef VMWAIT
#undef WGBAR
#undef QFRAG
    { const float rli = __builtin_amdgcn_rcpf(l_reg);
      int lane_e = lane; asm volatile("" : "+v"(lane_e));
      const int orow = B.orow0 + wid * 32 + (lane_e & 31), ocol = B.ocol0 + (lane_e >> 5) * 8;
#pragma unroll
      for (int d0 = 0; d0 < 4; ++d0)
#pragma unroll
          for (int g = 0; g < 4; g += 2) {
              unsigned ax = cvtpk(o[d0][4 * g] * rli, o[d0][4 * g + 1] * rli), ay = cvtpk(o[d0][4 * g + 2] * rli, o[d0][4 * g + 3] * rli);
              unsigned bx_ = cvtpk(o[d0][4 * g + 4] * rli, o[d0][4 * g + 5] * rli), by = cvtpk(o[d0][4 * g + 6] * rli, o[d0][4 * g + 7] * rli);
              { auto r = __builtin_amdgcn_permlane32_swap(ax, bx_, false, false); ax = r[0]; bx_ = r[1]; }
              { auto r = __builtin_amdgcn_permlane32_swap(ay, by, false, false); ay = r[0]; by = r[1]; }
              *(u32x4*)(B.O + act_off(orow, ocol + d0 * 32 + g * 8, T, DM)) = (u32x4){ax, ay, bx_, by}; } }
}

__device__ __forceinline__ void build_decay(char* lds, const float* lf, int n, const int wv) {
    int tid = tid_of(wv); asm volatile("" : "+v"(tid));
    const int wid = __builtin_amdgcn_readfirstlane(tid >> 6), lane = tid & 63;
    float* DL = (float*)(lds + l_dl(128)); float* scw = (float*)(lds + L_SC);
    float v[8]; const bool act = 8 * tid < n;
    { f32x4 a = act ? ld4(lf + 8 * tid) : (f32x4){0.f, 0.f, 0.f, 0.f}, b = act ? ld4(lf + 8 * tid + 4) : (f32x4){0.f, 0.f, 0.f, 0.f};
      v[0] = a[0]; v[1] = a[1]; v[2] = a[2]; v[3] = a[3]; v[4] = b[0]; v[5] = b[1]; v[6] = b[2]; v[7] = b[3]; }
#pragma unroll
    for (int e = 1; e < 8; ++e) v[e] += v[e - 1];
    const float tot = v[7]; float inc = tot;
#pragma unroll
    for (int o = 1; o < 64; o <<= 1) { const float y = __int_as_float(__builtin_amdgcn_ds_bpermute((lane - o) << 2, __float_as_int(inc))); if (lane >= o) inc += y; }
    if (lane == 63) scw[wid] = inc;
    __syncthreads();
    float base = inc - tot;
    for (int w = 0; w < wid; ++w) base += scw[w];
    if (act) {
#pragma unroll
        for (int e = 0; e < 8; ++e) DL[8 * tid + e] = -(base + v[e]) * LOG2E; }
}
}

constexpr size_t MiB = 1u << 20, KiB = 1u << 10;
constexpr size_t WS_CTL = 0, CTL_ZERO_BYTES = 1 * MiB;
constexpr size_t WS_RSTD0 = 1 * MiB;
constexpr size_t WS_RSTDM = WS_RSTD0 + 64 * KiB;
constexpr size_t WS_KRSS = WS_RSTDM + 64 * KiB;
constexpr size_t WS_MKSS = WS_KRSS + 128 * KiB;
constexpr size_t WS_CKVSS = WS_MKSS + 64 * KiB;
constexpr size_t WS_MQSS = WS_CKVSS + 512 * KiB;
constexpr size_t WS_CQSS = WS_MQSS + 1 * MiB;
constexpr size_t WS_LOGF = WS_CQSS + 1536 * KiB;
constexpr size_t WS_COS = WS_LOGF + 1536 * KiB;
constexpr size_t WS_SIN = WS_COS + 2 * MiB;
constexpr size_t WS_RSSA = WS_SIN + 2 * MiB;
constexpr size_t WS_RSSB = WS_RSSA + 4 * MiB;
constexpr size_t WS_KSS = WS_RSSB + 4 * MiB;
constexpr size_t WS_QSS = WS_KSS + 6 * MiB;
constexpr size_t WS_KSS1 = WS_QSS + 12 * MiB;
constexpr size_t WS_QSS1 = WS_KSS1 + 6 * MiB;
constexpr size_t WS_MQSS1 = WS_QSS1 + 12 * MiB;
constexpr size_t WS_SMALL_END = WS_MQSS1 + 1 * MiB;
static_assert(WS_SMALL_END <= 64 * MiB, "small arrays");
constexpr size_t WS_W_MEMKV = 64 * MiB;
constexpr size_t WS_W_FOXIN = WS_W_MEMKV + 16 * MiB;
constexpr size_t WS_W_O0 = WS_W_FOXIN + 82 * MiB, WS_W_O1 = WS_W_O0 + 32 * MiB;
constexpr size_t WS_W_UP0 = WS_W_O1 + 32 * MiB, WS_W_UP1 = WS_W_UP0 + 128 * MiB;
constexpr size_t WS_W_DN0 = WS_W_UP1 + 128 * MiB, WS_W_DN1 = WS_W_DN0 + 128 * MiB;
constexpr size_t WS_W_MLAIN = WS_W_DN1 + 128 * MiB;
constexpr size_t WS_W_QB = WS_W_MLAIN + 26 * MiB;
constexpr size_t WS_W_KVB = WS_W_QB + 14 * MiB;
constexpr size_t WS_XB = WS_W_KVB + 6 * MiB;
constexpr size_t WS_MEMN = WS_XB + 128 * MiB;
constexpr size_t WS_MK = WS_MEMN + 8 * MiB, WS_MV = WS_MK + 2 * MiB;
constexpr size_t WS_BIG = WS_MV + 2 * MiB;
constexpr size_t WS_HID = WS_BIG;
constexpr size_t WS_FQ = WS_BIG, WS_FK = WS_BIG + 96 * MiB, WS_FV = WS_BIG + 192 * MiB, WS_QM = WS_BIG + 288 * MiB, WS_MIX = WS_BIG + 320 * MiB;
constexpr size_t WS_CQ = WS_BIG, WS_CKV = WS_BIG + 48 * MiB, WS_RK = WS_BIG + 64 * MiB, WS_QM1 = WS_BIG + 68 * MiB, WS_QN = WS_BIG + 100 * MiB,
                 WS_QR = WS_BIG + 196 * MiB, WS_KN = WS_BIG + 244 * MiB, WS_VV = WS_BIG + 340 * MiB, WS_MIX1 = WS_BIG + 436 * MiB;
constexpr size_t WS_END = WS_BIG + 576 * MiB;
static_assert(WS_FV - WS_FK == WS_FK - WS_FQ, "Q | K | V equally spaced");
static_assert((size_t)FOXN * DM * 2 <= 82 * MiB && (size_t)MLAN * DM * 2 <= 26 * MiB && (size_t)QBN * QLR * 2 <= 14 * MiB, "weight slots");
constexpr int CW_BAR = 4096;

constexpr int RING_BYTES = 131072;
constexpr int L_TA = 135168, L_TB = 143360;
constexpr int MISC_OFF = 163328;
constexpr int LDS_BYTES = 163840;
constexpr int NWAVES = 8;
#ifndef ATT_MEM
#define ATT_MEM 1
#endif
#ifndef ATT_SELF
#define ATT_SELF 1
#endif
#ifndef PHASES
#define PHASES 0xFFF
#endif
#ifndef ATT_WRAP
#define ATT_WRAP 1
#endif
#ifndef REP_UP
#define REP_UP 1
#endif
#ifndef REP_WO
#define REP_WO 1
#endif
#ifndef REP_IN
#define REP_IN 1
#endif
#ifndef REP_DN
#define REP_DN 1
#endif
#ifndef W_BLK
#define W_BLK 1
#endif
#ifndef REP_P0
#define REP_P0 1
#endif
#ifndef REP_ATT
#define REP_ATT 1
#endif

#define XB_TMO      128
#define XB_XCNT(j)  (256  + 64 * (j))
#define XB_XSUB(j)  (1280 + 64 * (j))
#define XB_XGEN(j)  (2304 + 64 * (j))
#define XB_TOP      3328
#define XB_TOPGEN   3392
#define XCD_BAR_WORDS 3456
#define XB_SPIN_CAP (1u << 18)
__device__ __forceinline__ unsigned xb_ld(unsigned* p)              { return __hip_atomic_load(p, __ATOMIC_RELAXED, __HIP_MEMORY_SCOPE_AGENT); }
__device__ __forceinline__ unsigned xb_add(unsigned* p, unsigned v) { return __hip_atomic_fetch_add(p, v, __ATOMIC_RELAXED, __HIP_MEMORY_SCOPE_AGENT); }
__device__ __forceinline__ unsigned xb_xcc_id() { return (unsigned)__builtin_amdgcn_s_getreg((3 << 11) | 20) & 0xFu; }
#define XB_SPIN(cond, bar) do { unsigned _sp = 0; while (cond) { __builtin_amdgcn_s_sleep(1); \
    if ((++_sp & 255u) == 0u) { if (xb_ld(&(bar)[XB_TMO])) break; if (_sp > XB_SPIN_CAP) { atomicAdd(&(bar)[XB_TMO], 1u); break; } } } } while (0)
struct XcdBarrier { unsigned* bar; unsigned x; volatile LAS unsigned* st; };
__device__ __forceinline__ XcdBarrier xcd_barrier_post(unsigned* bar, volatile LAS unsigned* st) {
    XcdBarrier b; b.bar = bar; b.x = xb_xcc_id(); b.st = st;
    if (threadIdx.x == 0) (void)xb_add(&bar[XB_XCNT(b.x)], 1u);
    return b;
}
__device__ __forceinline__ void xcd_barrier_complete(unsigned* bar, unsigned x, unsigned& nloc, unsigned& nx) {
    const unsigned G = gridDim.x * gridDim.y * gridDim.z;
    unsigned sum, cnt, mine, sp = 0u;
    for (;;) {
        sum = 0u; cnt = 0u; mine = 0u;
#pragma unroll
        for (unsigned j = 0; j < 16; ++j) { const unsigned c = xb_ld(&bar[XB_XCNT(j)]); sum += c; cnt += (c > 0u) ? 1u : 0u; mine = (j == x) ? c : mine; }
        if (sum == G) break;
        __builtin_amdgcn_s_sleep(1);
        if ((++sp & 255u) == 0u) { if (xb_ld(&bar[XB_TMO])) break; if (sp > XB_SPIN_CAP) { atomicAdd(&bar[XB_TMO], 1u); break; } }
    }
    nloc = mine > 0u ? mine : 1u; nx = cnt > 0u ? cnt : 1u;
}
__device__ __forceinline__ void xcd_barrier(const XcdBarrier& b, const int wv) {
    asm volatile("s_waitcnt vmcnt(0)" ::: "memory");
    __syncthreads();
    if (wv == 0 && lane_id() == 0) {
        unsigned* bar = b.bar;
        __builtin_amdgcn_s_waitcnt(0);
        unsigned nloc = b.st[0], nx = b.st[1];
        if (nloc == 0u) { xcd_barrier_complete(bar, b.x, nloc, nx); b.st[0] = nloc; b.st[1] = nx; }
        const unsigned old = xb_add(&bar[XB_XSUB(b.x)], 1u);
        const unsigned gen = old / nloc;
        if (old + 1u == (gen + 1u) * nloc) {
            __builtin_amdgcn_fence(__ATOMIC_RELEASE, "agent");
            asm volatile("s_waitcnt vmcnt(0)" ::: "memory");
            const unsigned og = xb_add(&bar[XB_TOP], 1u);
            const unsigned tg = og / nx;
            if (og + 1u == (tg + 1u) * nx) xb_add(&bar[XB_TOPGEN], 1u);
            else XB_SPIN(xb_ld(&bar[XB_TOPGEN]) == tg, bar);
            __builtin_amdgcn_fence(__ATOMIC_ACQUIRE, "agent");
            xb_add(&bar[XB_XGEN(b.x)], 1u);
            asm volatile("s_waitcnt vmcnt(0)" ::: "memory");
        } else {
            XB_SPIN(xb_ld(&bar[XB_XGEN(b.x)]) == gen, bar);
            __builtin_amdgcn_fence(__ATOMIC_ACQUIRE, "agent");
            asm volatile("s_waitcnt vmcnt(0)" ::: "memory");
        }
    }
    __syncthreads();
}

#define LDS_WAIT() asm volatile("s_waitcnt lgkmcnt(0)" ::: "memory")
__device__ __forceinline__ float wave_sum(float v) {
#pragma unroll
    for (int o = 1; o < 64; o <<= 1) v += __shfl_xor(v, o);
    return v;
}
__device__ __forceinline__ int rope_rho(int s) { return 16 * (s >> 5) + 4 * ((s >> 3) & 3) + (s & 3) + 32 * ((s >> 2) & 1); }
__device__ __forceinline__ int src4(int kind, int n) {
    if (kind == 0) return n;
    if (kind == 1) return n < 9216 ? n : (n < 10240 ? n + 24 : (n < 10264 ? n - 1024 : -1));
    if (kind == 2) return n < 2048 ? n : (n < 3072 ? n + 64 : (n < 3136 ? 2048 + rope_rho(n - 3072) : -1));
    if (kind == 3) { if (n < 3072) return (n >> 7) * 192 + (n & 127); const int m = n - 3072; return (m >> 6) * 192 + 128 + rope_rho(m & 63); }
    { if (n < 3072) return (n >> 7) * 256 + (n & 127); const int m = n - 3072; return (m >> 7) * 256 + 128 + (m & 127); }
}
#define CONV_LOAD(V, it_) do { const int kb_ = (it_) / nblk, nb_ = (it_) - kb_ * nblk; const int sc_ = src4(kind, 32 * nb_ + 4 * g); \
        _Pragma("unroll") for (int i = 0; i < 8; ++i) { const int k_ = 64 * kb_ + 8 * i + kr; \
            V[i] = sc_ >= 0 ? ld4(W + (size_t)k_ * Nsrc + sc_) : (f32x4){0.f, 0.f, 0.f, 0.f}; } } while (0)
#define CONV_EMIT(V, it_) do { const int kb_ = (it_) / nblk, nb_ = (it_) - kb_ * nblk, k0_ = 64 * kb_, n0_ = 32 * nb_; \
        _Pragma("unroll") for (int i = 0; i < 8; ++i) { f32x4 v_ = V[i]; if (gf) v_ = v_ * gf[k0_ + 8 * i + kr]; \
            LAS float* s_ = scr + (8 * i + kr) * 33 + 4 * g; s_[0] = v_[0]; s_[1] = v_[1]; s_[2] = v_[2]; s_[3] = v_[3]; } \
        LDS_WAIT(); asm volatile("" ::: "memory"); \
        _Pragma("unroll") for (int j = 0; j < 4; ++j) { const int n_ = (lane >> 3) + 8 * j; const LAS float* s_ = scr + (8 * c) * 33 + n_; \
            u32x4 o_; o_.x = pg8::cvt_pk_bf16(s_[0 * 33], s_[1 * 33]); o_.y = pg8::cvt_pk_bf16(s_[2 * 33], s_[3 * 33]); o_.z = pg8::cvt_pk_bf16(s_[4 * 33], s_[5 * 33]); o_.w = pg8::cvt_pk_bf16(s_[6 * 33], s_[7 * 33]); \
            *(u32x4*)(WT + (blk ? ((size_t)kb_ * Ndst + (n0_ + n_)) * 64 + 8 * c : (size_t)(n0_ + n_) * K + k0_ + 8 * c)) = o_; } \
        LDS_WAIT(); asm volatile("" ::: "memory"); } while (0)
__device__ __forceinline__ void conv_matrix(const float* W, int K, int Nsrc, int Ndst, int kind, const float* gf, bf16* WT, LAS float* scr, int gw, int NGW, int lane, const int blk = 0) {
    const int nblk = Ndst / 32, nitems = (K / 64) * nblk;
    const int g = lane & 7, kr = lane >> 3, c = lane & 7;
    f32x4 va[8], vb[8];
    int it = gw; if (it >= nitems) return;
    CONV_LOAD(va, it);
    for (;;) {
        const int i1 = it + NGW; if (i1 < nitems) CONV_LOAD(vb, i1);
        CONV_EMIT(va, it);
        if (i1 >= nitems) break;
        const int i2 = i1 + NGW; if (i2 < nitems) CONV_LOAD(va, i2);
        CONV_EMIT(vb, i1);
        if (i2 >= nitems) break;
        it = i2;
    }
}
#undef CONV_LOAD
#undef CONV_EMIT
__device__ __forceinline__ void row_to_bf16_rstd(const float* xrow, bf16* obase, int m, int M, float* rstd, int lane) {
    const f32x4* xr = (const f32x4*)xrow + lane; float s = 0.f; f32x4 v[16];
#pragma unroll
    for (int j = 0; j < 16; ++j) { v[j] = xr[64 * j]; s += ss4(v[j]); }
    s = wave_sum(s);
    if (lane == 0) *rstd = rsqrtf(s * (1.f / DM) + EPS);
#pragma unroll
    for (int j = 0; j < 16; ++j) { u32x2 w; w.x = pg8::cvt_pk_bf16(v[j][0], v[j][1]); w.y = pg8::cvt_pk_bf16(v[j][2], v[j][3]); *(u32x2*)(obase + act_off(m, 256 * j + 4 * lane, M, DM)) = w; }
}
__device__ __forceinline__ void build_rtab(LAS float* tab, const float* src, int np, int rbase, int nrows, float inv_dim, const int wv) {
    int t0 = tid_of(wv); asm volatile("" : "+v"(t0));
    for (int r = t0; r < nrows; r += NWAVES * 64) {
        if (np == 0) { tab[r] = src[rbase + r]; continue; }
        const float* p = src + (size_t)(rbase + r) * np; float s = 0.f;
        for (int i = 0; i < np; i += 4) { const f32x4 v = ld4(p + i); s += (v[0] + v[1]) + (v[2] + v[3]); }
        tab[r] = rsqrtf(s * inv_dim + EPS);
    }
}

struct Args {
    const float *x, *mem; const int* pos; const float *mem_norm_g, *w_mem_kv, *mem_k_norm_g, *attn_norm_g, *memq_norm_g, *w_o, *mlp_norm_g, *w_up, *w_down,
        *fox_w_in, *fox_b_f, *fox_q_norm_g, *fox_k_norm_g, *mla_w_in, *mla_q_a_norm_g, *mla_w_q_b, *mla_kv_a_norm_g, *mla_w_kv_b, *mla_q_norm_g, *mla_k_norm_g;
    float* out; unsigned char* ws;
};
struct ArgsG {
    const GAS float *x, *mem; const GAS int* pos; const GAS float *mem_norm_g, *w_mem_kv, *mem_k_norm_g, *attn_norm_g, *memq_norm_g, *w_o, *mlp_norm_g, *w_up, *w_down,
        *fox_w_in, *fox_b_f, *fox_q_norm_g, *fox_k_norm_g, *mla_w_in, *mla_q_a_norm_g, *mla_w_q_b, *mla_kv_a_norm_g, *mla_w_kv_b, *mla_q_norm_g, *mla_k_norm_g;
    GAS float* out; GAS unsigned char* ws;
};
static_assert(sizeof(ArgsG) == sizeof(Args) && sizeof(Args) == 25 * 8, "argument block");
__device__ __forceinline__ Args to_generic(const ArgsG& g) {
    Args a;
    a.x = (const float*)g.x; a.mem = (const float*)g.mem; a.pos = (const int*)g.pos; a.mem_norm_g = (const float*)g.mem_norm_g; a.w_mem_kv = (const float*)g.w_mem_kv;
    a.mem_k_norm_g = (const float*)g.mem_k_norm_g; a.attn_norm_g = (const float*)g.attn_norm_g; a.memq_norm_g = (const float*)g.memq_norm_g; a.w_o = (const float*)g.w_o;
    a.mlp_norm_g = (const float*)g.mlp_norm_g; a.w_up = (const float*)g.w_up; a.w_down = (const float*)g.w_down; a.fox_w_in = (const float*)g.fox_w_in; a.fox_b_f = (const float*)g.fox_b_f;
    a.fox_q_norm_g = (const float*)g.fox_q_norm_g; a.fox_k_norm_g = (const float*)g.fox_k_norm_g; a.mla_w_in = (const float*)g.mla_w_in; a.mla_q_a_norm_g = (const float*)g.mla_q_a_norm_g;
    a.mla_w_q_b = (const float*)g.mla_w_q_b; a.mla_kv_a_norm_g = (const float*)g.mla_kv_a_norm_g; a.mla_w_kv_b = (const float*)g.mla_w_kv_b; a.mla_q_norm_g = (const float*)g.mla_q_norm_g;
    a.mla_k_norm_g = (const float*)g.mla_k_norm_g; a.out = (float*)g.out; a.ws = (unsigned char*)g.ws;
    return a;
}

__global__ void __launch_bounds__(NWAVES * 64, 2) mk_fwd(ArgsG a_in) {
    extern __shared__ __attribute__((aligned(16))) unsigned char lds[];
    LAS unsigned char* L = (LAS unsigned char*)lds;
    const int tid0 = threadIdx.x, wave = __builtin_amdgcn_readfirstlane(tid0 >> 6);
    const int G = gridDim.x, bx = blockIdx.x;
    unsigned char* ws0 = (unsigned char*)a_in.ws;
    volatile LAS unsigned* MISC = (volatile LAS unsigned*)(L + MISC_OFF);
    if (tid0 < 64) MISC[tid0] = 0u;
    __syncthreads();
    XcdBarrier bar = xcd_barrier_post((unsigned*)(ws0 + WS_CTL) + CW_BAR, MISC + 8);
    const int rbase = 2048 * (bx & 7);
    LAS float* TA = (LAS float*)(L + L_TA); LAS float* TB = (LAS float*)(L + L_TB);
#if defined(__HIP_DEVICE_COMPILE__)
#define LOAD_ARGS(a, ap) const ArgsG ag_ = *(ap); const Args a = to_generic(ag_)
#else
#define LOAD_ARGS(a, ap) const Args a = to_generic(a_in)
#endif
#define PHASE_VARS const __attribute__((address_space(4))) ArgsG* ap_ = (const __attribute__((address_space(4))) ArgsG*)__builtin_amdgcn_kernarg_segment_ptr(); asm volatile("" : "+s"(ap_)); LOAD_ARGS(a, ap_); \
    GAS unsigned char* wsg_ = (GAS unsigned char*)a.ws; asm volatile("" : "+s"(wsg_)); unsigned char* ws = (unsigned char*)wsg_; int tid = tid_of(wave); asm volatile("" : "+v"(tid)); (void)tid; const int lane = tid & 63; (void)lane; \
    bf16* XB = (bf16*)(ws + WS_XB); float* RSSA = (float*)(ws + WS_RSSA); float* RSSB = (float*)(ws + WS_RSSB); float* COS = (float*)(ws + WS_COS); float* SIN = (float*)(ws + WS_SIN); \
    float* MQSS = (float*)(ws + WS_MQSS); float* QSS = (float*)(ws + WS_QSS); float* KSS = (float*)(ws + WS_KSS); \
    float* MQSS1 = (float*)(ws + WS_MQSS1); float* QSS1 = (float*)(ws + WS_QSS1); float* KSS1 = (float*)(ws + WS_KSS1); (void)MQSS1; (void)QSS1; (void)KSS1; \
    (void)XB; (void)RSSA; (void)RSSB; (void)COS; (void)SIN; (void)MQSS; (void)QSS; (void)KSS;

    if constexpr ((PHASES >> 0) & 1)
    for (int rep_ = 0; rep_ < REP_P0; ++rep_)
    { PHASE_VARS
        const int vcu = (G % 8 == 0) ? (bx % 8) * (G / 8) + bx / 8 : bx;
        const int gw = vcu * NWAVES + wave, NGW = G * NWAVES;
        LAS float* scr = (LAS float*)(L + wave * 16384);
        conv_matrix(a.fox_w_in, DM, FOX_SRC, FOXN, 1, a.attn_norm_g, (bf16*)(ws + WS_W_FOXIN), scr, gw, NGW, lane, W_BLK);
        if (G != 256) conv_matrix(a.w_o + (size_t)DM * DM, DM, DM, DM, 0, nullptr, (bf16*)(ws + WS_W_O1), scr, gw, NGW, lane, W_BLK);
        conv_matrix(a.w_mem_kv, DM, 2048, 2048, 0, a.mem_norm_g, (bf16*)(ws + WS_W_MEMKV), scr, gw, NGW, lane, W_BLK);
        for (int m = gw; m < T; m += NGW) row_to_bf16_rstd(a.x + (size_t)m * DM, XB, m, T, (float*)(ws + WS_RSTD0) + m, lane);
        for (int m = gw; m < MT; m += NGW) row_to_bf16_rstd(a.mem + (size_t)m * DM, (bf16*)(ws + WS_MEMN), m, MT, (float*)(ws + WS_RSTDM) + m, lane);
        for (int idx = (vcu * NWAVES * 64) + tid; idx < T * 32; idx += G * NWAVES * 64) {
            const int tok = idx >> 5, i = idx & 31;
            const float invf = 1.0f / powf(10000.0f, (float)(2 * i) * (1.0f / 64.0f));
            const float ang = (float)a.pos[tok] * invf; float sn, cs; sincosf(ang, &sn, &cs);
            COS[idx] = cs; SIN[idx] = sn;
        }
    }
    xcd_barrier(bar, wave);

    if constexpr ((PHASES >> 1) & 1)
    for (int rep_ = 0; rep_ < REP_IN; ++rep_)
    { PHASE_VARS if (rep_) __syncthreads();
        build_rtab(TA, (const float*)(ws + WS_RSTD0), 0, rbase, 2048, 0.f, wave);
        build_rtab(TB, (const float*)(ws + WS_RSTDM), 0, 0, MT, 0.f, wave);
        __syncthreads();
        { pg8::Gemm g{(const bf16*)(ws + WS_MEMN), (const bf16*)(ws + WS_W_MEMKV), MT, 2048, DM, W_BLK, A_BLK}; pg8::StaticOrder S; S.init(MT, 2048, G, (bx >= 64 && bx < 96) ? bx - 64 : (1 << 20));
          EpiMemKV E{(bf16*)(ws + WS_MK), (bf16*)(ws + WS_MV), (float*)(ws + WS_MKSS), TB, 0};
          pg8::gemm_phase<EpiMemKV, pg8::StaticOrder, true, true>(L, g, S, E, wave); }
        { pg8::Gemm g{XB, (const bf16*)(ws + WS_W_FOXIN), T, FOXN, DM, W_BLK, A_BLK}; pg8::StaticOrder S; S.init(T, FOXN, G, bx);
          EpiFoxIn E{(bf16*)(ws + WS_FQ), (bf16*)(ws + WS_QM), (WS_FK - WS_FQ) / 2, QSS, KSS, MQSS, (float*)(ws + WS_LOGF),
                     a.fox_q_norm_g, a.fox_k_norm_g, a.memq_norm_g, a.mem_k_norm_g, a.fox_b_f, TA, rbase, (LAS float*)(L + 151552)};
          pg8::gemm_phase<EpiFoxIn, pg8::StaticOrder, true, true>(L, g, S, E, wave); }
        if (G == 256 && bx >= 96) conv_matrix(a.w_up + (size_t)DM * FF, DM, FF, FF, 0, a.mlp_norm_g + DM, (bf16*)(ws + WS_W_UP1), (LAS float*)(L + wave * 16384), (bx - 96) * NWAVES + wave, 160 * NWAVES, lane, W_BLK);
        else if (G != 256) conv_matrix(a.w_up + (size_t)DM * FF, DM, FF, FF, 0, a.mlp_norm_g + DM, (bf16*)(ws + WS_W_UP1), (LAS float*)(L + wave * 16384), bx * NWAVES + wave, G * NWAVES, lane, W_BLK);
    }
    xcd_barrier(bar, wave);

    if constexpr ((PHASES >> 2) & 1)
    for (int rep_ = 0; rep_ < REP_ATT; ++rep_)
    { PHASE_VARS if (rep_) __syncthreads();
        char* al = (char*)lds;
#define P2_CONV() do { const int vcu = (G % 8 == 0) ? (bx % 8) * (G / 8) + bx / 8 : bx; const int gw = vcu * NWAVES + wave, NGW = G * NWAVES; LAS float* scr = (LAS float*)(L + wave * 16384); \
            __syncthreads(); \
            conv_matrix(a.w_o, DM, DM, DM, 0, nullptr, (bf16*)(ws + WS_W_O0), scr, gw, NGW, lane, W_BLK); \
            conv_matrix(a.w_up, DM, FF, FF, 0, a.mlp_norm_g, (bf16*)(ws + WS_W_UP0), scr, gw, NGW, lane, W_BLK); \
            conv_matrix(a.w_down, FF, DM, DM, 0, nullptr, (bf16*)(ws + WS_W_DN0), scr, gw, NGW, lane, W_BLK); \
            conv_matrix(a.mla_w_in, DM, MLA_SRC, MLAN, 2, a.attn_norm_g + DM, (bf16*)(ws + WS_W_MLAIN), scr, gw, NGW, lane, W_BLK); \
            conv_matrix(a.mla_w_q_b, QLR, QBN, QBN, 3, a.mla_q_a_norm_g, (bf16*)(ws + WS_W_QB), scr, gw, NGW, lane, W_BLK); \
            conv_matrix(a.mla_w_kv_b, KVLR, KVBN, KVBN, 4, a.mla_kv_a_norm_g, (bf16*)(ws + WS_W_KVB), scr, gw, NGW, lane, W_BLK); \
            __syncthreads(); } while (0)
        if (rep_ == 0 && (bx & 1)) P2_CONV();
        asm volatile("" ::: "memory");
        float skip_th;
        { float gm = 0.f; for (int d = 0; d < 128; d += 4) { const f32x4 g4 = ld4(a.fox_q_norm_g + d) * ld4(a.fox_k_norm_g + d); gm = fmaxf(fmaxf(gm, fmaxf(fabsf(g4[0]), fabsf(g4[1]))), fmaxf(fabsf(g4[2]), fabsf(g4[3]))); }
          skip_th = 34.f * gm + 136.f + 8.f; }
        if constexpr (ATT_SELF) for (int i = 0;; ++i) {
            int Lid = i * G + bx; if (Lid >= 768 * ATT_WRAP) break; Lid = Lid >= 768 ? Lid - 768 : Lid;
            const int xcd = Lid & 7, k = Lid >> 3, bh = xcd * 12 + (k >> 3), x = ((k & 7) + 3 * (k >> 5)) & 7, b = bh / NH, h = bh - b * NH;
            const int nkeys = 256 * (16 - x);
            att::build_decay(al, (const float*)(ws + WS_LOGF) + (size_t)bh * SEQ, nkeys, wave);
            { int tl = tid_of(wave); asm volatile("" : "+v"(tl)); float* RKt = (float*)(al + att::l_rk(128)); const float* kp = KSS + ((size_t)b * SEQ * NH + h) * 4;
              for (int s = tl; s < nkeys; s += NWAVES * 64) { const f32x4 p = ld4(kp + (size_t)s * NH * 4); RKt[s] = rsqrtf(((p[0] + p[1]) + (p[2] + p[3])) * (1.f / 128.f) + EPS) * (0.08838834764831845f * LOG2E); } }
            __syncthreads();
            for (int pass = 0; pass < 2; ++pass) {
                const int qb = pass ? 15 - x : x; const size_t r0 = (size_t)b * SEQ + qb * 256;
                att::Blk B;
                B.Qa = (const bf16*)(ws + WS_FQ) + ((size_t)h * T + r0) * 128; B.Qb = B.Qa;
                B.Ka = (const bf16*)(ws + WS_FK) + ((size_t)h * T + (size_t)b * SEQ) * 128; B.Kb = B.Ka;
                B.V = (const bf16*)(ws + WS_FV) + ((size_t)h * T + (size_t)b * SEQ) * 128;
                B.O = (bf16*)(ws + WS_MIX); B.orow0 = (int)r0; B.ocol0 = h * 128;
                B.qssp = QSS + (r0 * NH + h) * 4;
                B.nkt = 4 * (qb + 1); B.qpos0 = qb * 256;
                { const float* NDLt = (const float*)(al + att::l_dl(128)); const int kt_ = lane_id(); const float ref_ = NDLt[qb * 256];
                  const bool need_ = kt_ < B.nkt && !(ref_ - NDLt[64 * kt_ + 63] > skip_th);
                  const unsigned long long mk_ = __ballot(need_); const int ktmin_ = mk_ ? (int)__builtin_ctzll(mk_) : 0;
                  B.nrun = B.nkt - __builtin_amdgcn_readfirstlane(ktmin_); }
                att::attn_block<128, 128, 4, true, true, true, true, att::Pitch<128, 128, 128, 128, 128, NH * 4>>(al, B, wave);
            }
        }
        if (rep_ == 0 && !(bx & 1)) P2_CONV();
#undef P2_CONV
        if constexpr (ATT_MEM) for (int u_ = bx; u_ < NB * NMH * 16 * ATT_WRAP; u_ += G) { const int u = u_ & 255;
            const int b = u >> 6, mh = (u >> 4) & 3, qb = u & 15; const size_t r0 = (size_t)b * SEQ + qb * 256;
            __syncthreads();
            { int tl = tid_of(wave); asm volatile("" : "+v"(tl)); float* RKt = (float*)(al + att::l_rk(256)); const float* kp = (const float*)(ws + WS_MKSS) + ((size_t)mh * MT + (size_t)b * MLEN) * 4;
              for (int s = tl; s < MLEN; s += NWAVES * 64) { const f32x4 p = ld4(kp + (size_t)s * 4); RKt[s] = rsqrtf(((p[0] + p[1]) + (p[2] + p[3])) * (1.f / 256.f) + EPS) * (0.0625f * LOG2E); } }
            __syncthreads();
            for (int pass = 0; pass < 2; ++pass) {
                att::Blk B;
                B.Qa = (const bf16*)(ws + WS_QM) + ((size_t)mh * T + r0) * 256; B.Qb = B.Qa;
                B.Ka = (const bf16*)(ws + WS_MK) + (size_t)b * MLEN * 1024 + mh * 256; B.Kb = B.Ka;
                B.V = (const bf16*)(ws + WS_MV) + (size_t)b * MLEN * 1024 + mh * 256 + pass * 128;
                B.O = (bf16*)(ws + WS_MIX); B.orow0 = (int)r0; B.ocol0 = 3072 + mh * 256 + pass * 128;
                B.qssp = MQSS + (r0 * NMH + mh) * 4;
                B.nkt = 4; B.nrun = 4; B.qpos0 = 0;
                att::attn_block<256, 256, 4, false, false, false, false, att::Pitch<256, 256, 1024, 1024, 1024, NMH * 4>>(al, B, wave);
            }
        }
    }
    xcd_barrier(bar, wave);

    if constexpr ((PHASES >> 3) & 1)
    for (int rep_ = 0; rep_ < REP_WO; ++rep_)
    { constexpr int REP_X = REP_WO; PHASE_VARS if (rep_) __syncthreads(); pg8::Gemm g{(const bf16*)(ws + WS_MIX), (const bf16*)(ws + WS_W_O0), T, DM, DM, W_BLK, A_BLK}; pg8::StaticOrder S; S.init(T, DM, G, bx);
      EpiRes<false> E{XB, (rep_ + 1 < REP_X) ? (bf16*)(ws + WS_END) : XB, nullptr, RSSA};
      pg8::gemm_phase<EpiRes<false>, pg8::StaticOrder, true, true>(L, g, S, E, wave); }
    xcd_barrier(bar, wave);

    if constexpr ((PHASES >> 4) & 1)
    for (int rep_ = 0; rep_ < REP_UP; ++rep_)
    { PHASE_VARS if (rep_) __syncthreads(); build_rtab(TA, RSSA, 64, rbase, 2048, 1.f / DM, wave); __syncthreads();
      pg8::Gemm g{XB, (const bf16*)(ws + WS_W_UP0), T, FF, DM, W_BLK, A_BLK}; pg8::StaticOrder S; S.init(T, FF, G, bx);
      EpiUp E{(bf16*)(ws + WS_HID), TA, rbase};
      pg8::gemm_phase<EpiUp, pg8::StaticOrder, true, true>(L, g, S, E, wave); }
    xcd_barrier(bar, wave);

    if constexpr ((PHASES >> 5) & 1)
    for (int rep_ = 0; rep_ < REP_DN; ++rep_)
    { constexpr int REP_X = REP_DN; PHASE_VARS if (rep_) __syncthreads(); pg8::Gemm g{(const bf16*)(ws + WS_HID), (const bf16*)(ws + WS_W_DN0), T, DM, FF, W_BLK, HID_BLK}; pg8::StaticOrder S; S.init(T, DM, G, bx);
      EpiRes<false> E{XB, (rep_ + 1 < REP_X) ? (bf16*)(ws + WS_END) : XB, nullptr, RSSB};
      pg8::gemm_phase<EpiRes<false>, pg8::StaticOrder, true, true>(L, g, S, E, wave); }
    xcd_barrier(bar, wave);

    if constexpr ((PHASES >> 6) & 1)
    for (int rep_ = 0; rep_ < REP_IN; ++rep_)
    { PHASE_VARS if (rep_) __syncthreads(); build_rtab(TA, RSSB, 64, rbase, 2048, 1.f / DM, wave); __syncthreads();
      pg8::Gemm g{XB, (const bf16*)(ws + WS_W_MLAIN), T, MLAN, DM, W_BLK, A_BLK}; pg8::StaticOrder S; S.init(T, MLAN, G, bx);
      EpiMlaIn E{(bf16*)(ws + WS_CQ), (bf16*)(ws + WS_CKV), (bf16*)(ws + WS_QM1), (bf16*)(ws + WS_RK), (float*)(ws + WS_CQSS), (float*)(ws + WS_CKVSS), MQSS1, (float*)(ws + WS_KRSS),
                 a.memq_norm_g + 256, a.mem_k_norm_g, a.mla_k_norm_g, COS, SIN, TA, rbase};
      pg8::gemm_phase<EpiMlaIn, pg8::StaticOrder, true, true>(L, g, S, E, wave);
      if (G == 256 && bx >= 64) conv_matrix(a.w_down + (size_t)FF * DM, FF, DM, DM, 0, nullptr, (bf16*)(ws + WS_W_DN1), (LAS float*)(L + wave * 16384), (bx - 64) * NWAVES + wave, 192 * NWAVES, lane, W_BLK);
      else if (G != 256) conv_matrix(a.w_down + (size_t)FF * DM, FF, DM, DM, 0, nullptr, (bf16*)(ws + WS_W_DN1), (LAS float*)(L + wave * 16384), bx * NWAVES + wave, G * NWAVES, lane, W_BLK); }
    xcd_barrier(bar, wave);

    if constexpr ((PHASES >> 7) & 1)
    for (int rep_ = 0; rep_ < REP_IN; ++rep_)
    { PHASE_VARS if (rep_) __syncthreads(); build_rtab(TA, (const float*)(ws + WS_CQSS), 24, rbase, 2048, 1.f / QLR, wave); build_rtab(TB, (const float*)(ws + WS_CKVSS), 8, rbase, 2048, 1.f / KVLR, wave); __syncthreads();
      { pg8::Gemm g{(const bf16*)(ws + WS_CQ), (const bf16*)(ws + WS_W_QB), T, QBN, QLR, W_BLK, A_BLK}; pg8::StaticOrder S; S.init(T, QBN, G, bx);
        EpiQB E{(bf16*)(ws + WS_QN), (bf16*)(ws + WS_QR), QSS1, a.mla_q_norm_g, a.mla_k_norm_g, COS, SIN, TA, rbase};
        pg8::gemm_phase<EpiQB, pg8::StaticOrder, true, true>(L, g, S, E, wave); }
      { pg8::Gemm g{(const bf16*)(ws + WS_CKV), (const bf16*)(ws + WS_W_KVB), T, KVBN, KVLR, W_BLK, A_BLK}; pg8::StaticOrder S; S.init(T, KVBN, G, (bx + 128) % G);
        EpiKVB E{(bf16*)(ws + WS_KN), (bf16*)(ws + WS_VV), KSS1, TB, rbase};
        pg8::gemm_phase<EpiKVB, pg8::StaticOrder, true, true>(L, g, S, E, wave); }
      if (G == 256 && bx >= 128) conv_matrix(a.w_o + (size_t)DM * DM, DM, DM, DM, 0, nullptr, (bf16*)(ws + WS_W_O1), (LAS float*)(L + wave * 16384), (bx - 128) * NWAVES + wave, 128 * NWAVES, lane, W_BLK);
}
    xcd_barrier(bar, wave);

    if constexpr ((PHASES >> 8) & 1)
    for (int rep_ = 0; rep_ < REP_ATT; ++rep_)
    { PHASE_VARS if (rep_) __syncthreads();
        char* al = (char*)lds;
        if constexpr (ATT_SELF) for (int i = 0;; ++i) {
            int Lid = i * G + bx; if (Lid >= 768 * ATT_WRAP) break; Lid = Lid >= 768 ? Lid - 768 : Lid;
            const int xcd = Lid & 7, k = Lid >> 3, bh = xcd * 12 + (k >> 3), x = k & 7, b = bh / NH, h = bh - b * NH;
            const int nkeys = 256 * (16 - x);
            __syncthreads();
            { int tl = tid_of(wave); asm volatile("" : "+v"(tl)); float* RKt = (float*)(al + att::l_rk(192)); const float* kp = KSS1 + ((size_t)b * SEQ * NH + h) * 4; const float* rp = (const float*)(ws + WS_KRSS) + (size_t)b * SEQ * 2;
              for (int s = tl; s < nkeys; s += NWAVES * 64) { const f32x4 p = ld4(kp + (size_t)s * NH * 4); const f32x2 q = *(const f32x2*)(rp + (size_t)s * 2);
                  RKt[s] = rsqrtf((((p[0] + p[1]) + (p[2] + p[3])) + (q[0] + q[1])) * (1.f / 192.f) + EPS) * (0.07216878364870323f * LOG2E); } }
            __syncthreads();
            for (int pass = 0; pass < 2; ++pass) {
                const int qb = pass ? 15 - x : x; const size_t r0 = (size_t)b * SEQ + qb * 256;
                att::Blk B;
                B.Qa = (const bf16*)(ws + WS_QN) + ((size_t)h * T + r0) * 128; B.Qb = (const bf16*)(ws + WS_QR) + ((size_t)h * T + r0) * 64;
                B.Ka = (const bf16*)(ws + WS_KN) + ((size_t)h * T + (size_t)b * SEQ) * 128; B.Kb = (const bf16*)(ws + WS_RK) + (size_t)b * SEQ * 64;
                B.V = (const bf16*)(ws + WS_VV) + ((size_t)h * T + (size_t)b * SEQ) * 128;
                B.O = (bf16*)(ws + WS_MIX1); B.orow0 = (int)r0; B.ocol0 = h * 128;
                B.qssp = QSS1 + (r0 * NH + h) * 8;
                B.nkt = 4 * (qb + 1); B.nrun = B.nkt; B.qpos0 = qb * 256;
                att::attn_block<192, 128, 6, true, false, true, false, att::Pitch<128, 64, 128, 64, 128, NH * 8>>(al, B, wave);
            }
        }
        if constexpr (ATT_MEM) for (int u_ = bx; u_ < NB * NMH * 16 * ATT_WRAP; u_ += G) { const int u = u_ & 255;
            const int b = u >> 6, mh = (u >> 4) & 3, qb = u & 15; const size_t r0 = (size_t)b * SEQ + qb * 256;
            __syncthreads();
            { int tl = tid_of(wave); asm volatile("" : "+v"(tl)); float* RKt = (float*)(al + att::l_rk(256)); const float* kp = (const float*)(ws + WS_MKSS) + ((size_t)mh * MT + (size_t)b * MLEN) * 4;
              for (int s = tl; s < MLEN; s += NWAVES * 64) { const f32x4 p = ld4(kp + (size_t)s * 4); RKt[s] = rsqrtf(((p[0] + p[1]) + (p[2] + p[3])) * (1.f / 256.f) + EPS) * (0.0625f * LOG2E); } }
            __syncthreads();
            for (int pass = 0; pass < 2; ++pass) {
                att::Blk B;
                B.Qa = (const bf16*)(ws + WS_QM1) + ((size_t)mh * T + r0) * 256; B.Qb = B.Qa;
                B.Ka = (const bf16*)(ws + WS_MK) + (size_t)b * MLEN * 1024 + mh * 256; B.Kb = B.Ka;
                B.V = (const bf16*)(ws + WS_MV) + (size_t)b * MLEN * 1024 + mh * 256 + pass * 128;
                B.O = (bf16*)(ws + WS_MIX1); B.orow0 = (int)r0; B.ocol0 = 3072 + mh * 256 + pass * 128;
                B.qssp = MQSS1 + (r0 * NMH + mh) * 4;
                B.nkt = 4; B.nrun = 4; B.qpos0 = 0;
                att::attn_block<256, 256, 4, false, false, false, false, att::Pitch<256, 256, 1024, 1024, 1024, NMH * 4>>(al, B, wave);
            }
        }
    }
    xcd_barrier(bar, wave);

    if constexpr ((PHASES >> 9) & 1)
    for (int rep_ = 0; rep_ < REP_WO; ++rep_)
    { constexpr int REP_X = REP_WO; PHASE_VARS if (rep_) __syncthreads(); pg8::Gemm g{(const bf16*)(ws + WS_MIX1), (const bf16*)(ws + WS_W_O1), T, DM, DM, W_BLK, A_BLK}; pg8::StaticOrder S; S.init(T, DM, G, bx);
      EpiRes<false> E{XB, (rep_ + 1 < REP_X) ? (bf16*)(ws + WS_END) : XB, nullptr, RSSA};
      pg8::gemm_phase<EpiRes<false>, pg8::StaticOrder, true, true>(L, g, S, E, wave); }
    xcd_barrier(bar, wave);

    if constexpr ((PHASES >> 10) & 1)
    for (int rep_ = 0; rep_ < REP_UP; ++rep_)
    { PHASE_VARS if (rep_) __syncthreads(); build_rtab(TA, RSSA, 64, rbase, 2048, 1.f / DM, wave); __syncthreads();
      pg8::Gemm g{XB, (const bf16*)(ws + WS_W_UP1), T, FF, DM, W_BLK, A_BLK}; pg8::StaticOrder S; S.init(T, FF, G, bx);
      EpiUp E{(bf16*)(ws + WS_HID), TA, rbase};
      pg8::gemm_phase<EpiUp, pg8::StaticOrder, true, true>(L, g, S, E, wave); }
    xcd_barrier(bar, wave);

    if constexpr ((PHASES >> 11) & 1)
    { PHASE_VARS pg8::Gemm g{(const bf16*)(ws + WS_HID), (const bf16*)(ws + WS_W_DN1), T, DM, FF, W_BLK, HID_BLK}; pg8::StaticOrder S; S.init(T, DM, G, bx);
      EpiRes<true> E{XB, XB, a.out, nullptr};
      pg8::gemm_phase<EpiRes<true>, pg8::StaticOrder, true, true>(L, g, S, E, wave); }
}

extern "C" void kernel_launch(void* const* d_in, const int* in_sizes, int n_in, void* d_out, int out_size, void* d_ws, size_t ws_size, hipStream_t stream) {
    static int grid = 0;
    if (grid == 0) {
        if (n_in != 23 || ws_size < WS_END) { fprintf(stderr, "kernel_launch: need 23 inputs and >= %zu bytes of workspace; got %d, %zu\n", (size_t)WS_END, n_in, ws_size); grid = -1; return; }
        int dev = 0, cus = 0, per_cu = 0;
        if (hipGetDevice(&dev) != hipSuccess || hipDeviceGetAttribute(&cus, hipDeviceAttributeMultiprocessorCount, dev) != hipSuccess) { grid = -1; return; }
        if (hipFuncSetAttribute((const void*)mk_fwd, hipFuncAttributeMaxDynamicSharedMemorySize, LDS_BYTES) != hipSuccess) { fprintf(stderr, "kernel_launch: hipFuncSetAttribute failed\n"); grid = -1; return; }
        if (hipOccupancyMaxActiveBlocksPerMultiprocessor(&per_cu, (const void*)mk_fwd, NWAVES * 64, LDS_BYTES) != hipSuccess || per_cu < 1) { fprintf(stderr, "kernel_launch: occupancy query says %d\n", per_cu); }
        (void)hipGetLastError();
        grid = cus;
        if (grid % 8 != 0) grid -= grid % 8;
    }
    if (grid <= 0) return;
    (void)hipMemsetAsync((char*)d_ws + WS_CTL, 0, CTL_ZERO_BYTES, stream);
    Args a{};
    a.x = (const float*)d_in[0]; a.mem = (const float*)d_in[1]; a.pos = (const int*)d_in[2]; a.mem_norm_g = (const float*)d_in[3]; a.w_mem_kv = (const float*)d_in[4];
    a.mem_k_norm_g = (const float*)d_in[5]; a.attn_norm_g = (const float*)d_in[6]; a.memq_norm_g = (const float*)d_in[7]; a.w_o = (const float*)d_in[8];
    a.mlp_norm_g = (const float*)d_in[9]; a.w_up = (const float*)d_in[10]; a.w_down = (const float*)d_in[11]; a.fox_w_in = (const float*)d_in[12]; a.fox_b_f = (const float*)d_in[13];
    a.fox_q_norm_g = (const float*)d_in[14]; a.fox_k_norm_g = (const float*)d_in[15]; a.mla_w_in = (const float*)d_in[16]; a.mla_q_a_norm_g = (const float*)d_in[17];
    a.mla_w_q_b = (const float*)d_in[18]; a.mla_kv_a_norm_g = (const float*)d_in[19]; a.mla_w_kv_b = (const float*)d_in[20]; a.mla_q_norm_g = (const float*)d_in[21];
    a.mla_k_norm_g = (const float*)d_in[22];
    a.out = (float*)d_out; a.ws = (unsigned char*)d_ws;
    ArgsG ag{}; static_assert(sizeof(ag) == sizeof(a), ""); memcpy(&ag, &a, sizeof(a));
    hipLaunchKernelGGL(mk_fwd, dim3(grid), dim3(NWAVES * 64), LDS_BYTES, stream, ag);
}
```
